# Optimizing an MI355X kernel written in HIP

```python
import math
import jax, jax.numpy as jnp
from jax import lax
import numpy as np

D_MODEL = 1024
BATCH = 4
SEQ = 4096
DEPTH = 2

GRID_W = 64
CTX_LEN = 256
N_MIXERS = 4
GROUP_WIDTH = D_MODEL // N_MIXERS
HEAD_DIM = 64
A_HEADS = GROUP_WIDTH // HEAD_DIM
A_KV_HEADS = A_HEADS // 2
WINDOW = 128
BLK = 128
B_HEADS = GROUP_WIDTH // HEAD_DIM
B_QK_DIM = HEAD_DIM // 2
C_HEADS = GROUP_WIDTH // HEAD_DIM
RET_CHUNK = 128
D_HEADS = GROUP_WIDTH // HEAD_DIM
NA_ROWS = 8
NA_COLS = 16
NA_QCB = 16
NA_KCB = 2 * NA_QCB
D_FF = 4 * D_MODEL
ROPE_BASE = 10000.0
EPS = 1e-6
NEG_INF = -1e30
IN_WIDTHS = (A_HEADS * HEAD_DIM, A_KV_HEADS * HEAD_DIM, A_KV_HEADS * HEAD_DIM,
             2 * B_HEADS * B_QK_DIM, 2 * B_HEADS * B_QK_DIM, B_HEADS * HEAD_DIM,
             C_HEADS * HEAD_DIM, C_HEADS * HEAD_DIM, C_HEADS * HEAD_DIM, C_HEADS * HEAD_DIM,
             D_HEADS * HEAD_DIM, D_HEADS * HEAD_DIM, D_HEADS * HEAD_DIM)
IN_WIDTH = sum(IN_WIDTHS)

kernel_name = 'hybrid_parallel_heads_dit_block'


def rms_norm(x, g):
    xf = x.astype(jnp.float32)
    y = xf * lax.rsqrt(jnp.mean(xf * xf, axis=-1, keepdims=True) + EPS)
    return (y * g.astype(jnp.float32)).astype(x.dtype)


def softmax_f32(s):
    return jax.nn.softmax(s.astype(jnp.float32), axis=-1)


def to_heads(t, n, d):
    b, l, _ = t.shape
    return t.reshape(b, l, n, d).transpose(0, 2, 1, 3)


def from_heads(t):
    b, n, l, d = t.shape
    return t.transpose(0, 2, 1, 3).reshape(b, l, n * d)


def to_diff_heads(t):
    b, l, _ = t.shape
    return t.reshape(b, l, B_HEADS, 2, B_QK_DIM).transpose(0, 2, 3, 1, 4)


def split_in(t):
    bounds = np.cumsum(IN_WIDTHS)[:-1].tolist()
    return jnp.split(t, bounds, axis=-1)


def rope_1d(x, pos):
    half = x.shape[-1] // 2
    freqs = ROPE_BASE ** (-jnp.arange(half, dtype=jnp.float32) / half)
    ang = pos[:, None] * freqs[None, :]
    cos, sin = jnp.cos(ang), jnp.sin(ang)
    xf = x.astype(jnp.float32)
    x1, x2 = xf[..., :half], xf[..., half:]
    return jnp.concatenate([x1 * cos - x2 * sin, x1 * sin + x2 * cos], axis=-1).astype(x.dtype)


def rope_2d(x, rows, cols):
    h = x.shape[-1] // 2
    return jnp.concatenate([rope_1d(x[..., :h], rows), rope_1d(x[..., h:], cols)], axis=-1)


def window_attention(q, k, v, k_ctx, v_ctx, sink):
    b, ha, l, dh = q.shape
    g = k.shape[1]
    rep = ha // g
    nb = l // BLK
    scale = dh ** -0.5
    qb = q.reshape(b, g, rep, nb, BLK, dh)

    def band(t):
        tp = jnp.pad(t, ((0, 0), (0, 0), (BLK, BLK), (0, 0))).reshape(b, g, nb + 2, BLK, dh)
        return jnp.concatenate([tp[:, :, :-2], tp[:, :, 1:-1], tp[:, :, 2:]], axis=3)

    kw, vw = band(k), band(v)
    s_win = jnp.einsum('bgrnqd,bgnkd->bgrnqk', qb, kw).astype(jnp.float32) * scale
    blk_id = np.arange(nb)[:, None, None]
    qpos = blk_id * BLK + np.arange(BLK)[None, :, None]
    kpos = (blk_id - 1) * BLK + np.arange(3 * BLK)[None, None, :]
    valid = (np.abs(qpos - kpos) <= WINDOW) & (kpos >= 0) & (kpos < l)
    s_win = jnp.where(valid, s_win, NEG_INF)
    s_ctx = jnp.einsum('bgrnqd,bgkd->bgrnqk', qb, k_ctx).astype(jnp.float32) * scale
    s_sink = jnp.broadcast_to(sink.astype(jnp.float32).reshape(g, rep, 1, 1, 1), s_ctx.shape[:-1] + (1,))
    prob = softmax_f32(jnp.concatenate([s_win, s_ctx, s_sink], axis=-1))
    n_ctx = k_ctx.shape[2]
    p_win = prob[..., :3 * BLK]
    p_ctx = prob[..., 3 * BLK:3 * BLK + n_ctx]
    o = jnp.einsum('bgrnqk,bgnkd->bgrnqd', p_win, vw) + jnp.einsum('bgrnqk,bgkd->bgrnqd', p_ctx, v_ctx)
    return o.reshape(b, ha, l, dh).astype(q.dtype)


def ctx_gqa_attention(q, k, v, sink):
    b, ha, n, dh = q.shape
    g = k.shape[1]
    rep = ha // g
    qg = q.reshape(b, g, rep, n, dh)
    s = jnp.einsum('bgrqd,bgkd->bgrqk', qg, k).astype(jnp.float32) * dh ** -0.5
    s_sink = jnp.broadcast_to(sink.astype(jnp.float32).reshape(g, rep, 1, 1), (b, g, rep, n, 1))
    prob = softmax_f32(jnp.concatenate([s, s_sink], axis=-1))[..., :-1]
    o = jnp.einsum('bgrqk,bgkd->bgrqd', prob, v)
    return o.reshape(b, ha, n, dh).astype(q.dtype)


def diff_probs(q, k, lam):
    s = jnp.einsum('bhjqd,bhjkd->bhjqk', q, k).astype(jnp.float32) * q.shape[-1] ** -0.5
    prob = softmax_f32(s)
    return prob[:, :, 0] - lam * prob[:, :, 1]


def diff_attention(q, k, v, k_ctx, v_ctx, lam):
    b, h, _, l, dk = q.shape
    nb = l // BLK
    k_all = jnp.concatenate([k, k_ctx], axis=3)
    v_all = jnp.concatenate([v, v_ctx], axis=2)
    q_blocks = jnp.moveaxis(q.reshape(b, h, 2, nb, BLK, dk), 3, 0)

    def one_block(qb):
        return jnp.einsum('bhqk,bhkd->bhqd', diff_probs(qb, k_all, lam), v_all)

    o = lax.map(one_block, q_blocks)
    return jnp.moveaxis(o, 0, 2).reshape(b, h, l, v.shape[-1])


def retention_scan(q, k, v, log_gamma, s0):
    b, h, l, dk = q.shape
    dv = v.shape[-1]
    n_chunks = l // RET_CHUNK
    idx = jnp.arange(RET_CHUNK, dtype=jnp.float32)
    lg = log_gamma[:, None]
    rel = idx[:, None] - idx[None, :]
    inner_decay = jnp.exp(jnp.where(rel[None] >= 0, rel[None] * lg[..., None], -jnp.inf))
    q_decay = jnp.exp((idx + 1.0)[None, :] * lg)[..., None]
    k_decay = jnp.exp((RET_CHUNK - 1.0 - idx)[None, :] * lg)[..., None]
    chunk_decay = jnp.exp(RET_CHUNK * lg)[..., None]

    def chunks(t):
        return jnp.moveaxis(t.reshape(b, h, n_chunks, RET_CHUNK, t.shape[-1]), 2, 0)

    def step(state, inp):
        qi, ki, vi = inp
        inner = jnp.einsum('bhid,bhjd->bhij', qi, ki) * inner_decay
        o = jnp.einsum('bhij,bhjv->bhiv', inner, vi) + jnp.einsum('bhid,bhdv->bhiv', qi * q_decay, state)
        state = state * chunk_decay + jnp.einsum('bhjd,bhjv->bhdv', ki * k_decay, vi)
        return state, o

    s_final, o = lax.scan(step, s0, (chunks(q), chunks(k), chunks(v)))
    return jnp.moveaxis(o, 0, 2).reshape(b, h, l, dv), s_final


def neighbourhood_attention(q, k, v, k_ctx, v_ctx, rpb):
    b, h, l, dh = q.shape
    rows = l // GRID_W
    kh = min(NA_ROWS, rows)
    ncb = GRID_W // NA_QCB
    scale = dh ** -0.5
    r = np.arange(rows)
    row_idx = np.clip(r - kh // 2, 0, rows - kh)[:, None] + np.arange(kh)[None, :]
    col_idx = (np.clip(np.arange(ncb) * NA_QCB - NA_COLS // 2, 0, GRID_W - NA_KCB)[:, None]
               + np.arange(NA_KCB)[None, :])
    qcol = np.arange(ncb)[:, None] * NA_QCB + np.arange(NA_QCB)[None, :]
    cstart = np.clip(qcol - NA_COLS // 2, 0, GRID_W - NA_COLS)[..., None]
    kcol = col_idx[:, None, :]
    col_valid = (kcol >= cstart) & (kcol < cstart + NA_COLS)
    dr = row_idx - r[:, None] + NA_ROWS - 1
    dc = np.clip(kcol - qcol[..., None] + NA_COLS - 1, 0, 2 * NA_COLS - 2)
    bias = rpb[:, dr[:, None, None, :, None], dc[None, :, :, None, :]]

    def gather(t):
        tg = t.reshape(b, h, rows, GRID_W, dh)
        return tg[:, :, row_idx[:, None, :, None], col_idx[None, :, None, :]]

    kg, vg = gather(k), gather(v)
    qg = q.reshape(b, h, rows, ncb, NA_QCB, dh)
    s = jnp.einsum('bhrjqd,bhrjkwd->bhrjqkw', qg, kg).astype(jnp.float32) * scale + bias.astype(jnp.float32)
    s = jnp.where(col_valid[:, :, None, :], s, NEG_INF).reshape(b, h, rows, ncb, NA_QCB, kh * NA_KCB)
    s_ctx = jnp.einsum('bhrjqd,bhkd->bhrjqk', qg, k_ctx).astype(jnp.float32) * scale
    prob = softmax_f32(jnp.concatenate([s, s_ctx], axis=-1))
    p_nb = prob[..., :kh * NA_KCB].reshape(b, h, rows, ncb, NA_QCB, kh, NA_KCB)
    p_ctx = prob[..., kh * NA_KCB:]
    o = jnp.einsum('bhrjqkw,bhrjkwd->bhrjqd', p_nb, vg) + jnp.einsum('bhrjqk,bhkd->bhrjqd', p_ctx, v_ctx)
    return o.reshape(b, h, l, dh).astype(q.dtype)


def dense_ctx_attention(q, k, v):
    s = jnp.einsum('bhqd,bhkd->bhqk', q, k).astype(jnp.float32) * q.shape[-1] ** -0.5
    return jnp.einsum('bhqk,bhkd->bhqd', softmax_f32(s), v).astype(q.dtype)


def squared_relu_mlp(h, w1, w2):
    return jnp.square(jax.nn.relu(h @ w1)) @ w2


def hybrid_layer(x, ctx, c, c_ctx, p, layer_idx, need_ctx):
    f32 = jnp.float32
    b, l, _ = x.shape
    pos = jnp.arange(l)
    rows = (pos // GRID_W).astype(f32)
    cols = (pos % GRID_W).astype(f32)

    mod_x = (jax.nn.silu(c) @ p['w_mod'] + p['b_mod'])[:, None, :]
    mod_c = (jax.nn.silu(c_ctx) @ p['w_mod'] + p['b_mod'])[None, None, :]
    sh1x, sc1x, g1x, sh2x, sc2x, g2x = jnp.split(mod_x, 6, axis=-1)
    sh1c, sc1c, g1c, sh2c, sc2c, g2c = jnp.split(mod_c, 6, axis=-1)

    hx = rms_norm(x, p['norm1_g']) * (1 + sc1x) + sh1x
    hc = rms_norm(ctx, p['norm1_g']) * (1 + sc1c) + sh1c
    (lw_q, lw_k, lw_v, lf_q, lf_k, lf_v, lr_q, lr_k, lr_v, lr_g, ln_q, ln_k, ln_v) = split_in(hx @ p['w_in'])
    (cw_q, cw_k, cw_v, cf_q, cf_k, cf_v, cr_q, cr_k, cr_v, cr_g, cn_q, cn_k, cn_v) = split_in(hc @ p['w_in'])

    q = rope_2d(rms_norm(to_heads(lw_q, A_HEADS, HEAD_DIM), p['a_qnorm_g']), rows, cols)
    k = rope_2d(rms_norm(to_heads(lw_k, A_KV_HEADS, HEAD_DIM), p['a_knorm_g']), rows, cols)
    v = to_heads(lw_v, A_KV_HEADS, HEAD_DIM)
    k_c = rms_norm(to_heads(cw_k, A_KV_HEADS, HEAD_DIM), p['a_knorm_g'])
    v_c = to_heads(cw_v, A_KV_HEADS, HEAD_DIM)
    out_w = window_attention(q, k, v, k_c, v_c, p['a_sink'])
    if need_ctx:
        q_c = rms_norm(to_heads(cw_q, A_HEADS, HEAD_DIM), p['a_qnorm_g'])
        cout_w = ctx_gqa_attention(q_c, k_c, v_c, p['a_sink'])

    lambda_init = 0.8 - 0.6 * math.exp(-0.3 * layer_idx)
    lam = (jnp.exp(jnp.sum(p['b_lambda_q1'].astype(f32) * p['b_lambda_k1'].astype(f32)))
           - jnp.exp(jnp.sum(p['b_lambda_q2'].astype(f32) * p['b_lambda_k2'].astype(f32))) + lambda_init)
    q = rope_2d(rms_norm(to_diff_heads(lf_q), p['b_qnorm_g']), rows, cols)
    k = rope_2d(rms_norm(to_diff_heads(lf_k), p['b_knorm_g']), rows, cols)
    v = to_heads(lf_v, B_HEADS, HEAD_DIM)
    k_c = rms_norm(to_diff_heads(cf_k), p['b_knorm_g'])
    v_c = to_heads(cf_v, B_HEADS, HEAD_DIM)
    out_f = (rms_norm(diff_attention(q, k, v, k_c, v_c, lam), p['b_subln_g']) * (1 - lambda_init)).astype(x.dtype)
    if need_ctx:
        q_c = rms_norm(to_diff_heads(cf_q), p['b_qnorm_g'])
        o_c = jnp.einsum('bhqk,bhkd->bhqd', diff_probs(q_c, k_c, lam), v_c)
        cout_f = (rms_norm(o_c, p['b_subln_g']) * (1 - lambda_init)).astype(x.dtype)

    lg_f = jax.nn.log_sigmoid(p['c_decay_fwd'].astype(f32))
    lg_b = jax.nn.log_sigmoid(p['c_decay_bwd'].astype(f32))
    k_scale = HEAD_DIM ** -0.5
    flip = lambda t: jnp.flip(t, axis=2)
    q = to_heads(lr_q, C_HEADS, HEAD_DIM)
    k = to_heads(lr_k, C_HEADS, HEAD_DIM) * k_scale
    v = to_heads(lr_v, C_HEADS, HEAD_DIM)
    q_c = to_heads(cr_q, C_HEADS, HEAD_DIM)
    k_c = to_heads(cr_k, C_HEADS, HEAD_DIM) * k_scale
    v_c = to_heads(cr_v, C_HEADS, HEAD_DIM)
    s0 = jnp.zeros((b, C_HEADS, HEAD_DIM, HEAD_DIM), f32)
    o_cf, s_f = retention_scan(q_c, k_c, v_c, lg_f, s0)
    o_cb, s_b = retention_scan(flip(q_c), flip(k_c), flip(v_c), lg_b, s0)
    o_f, _ = retention_scan(q, k, v, lg_f, s_f)
    o_b, _ = retention_scan(flip(q), flip(k), flip(v), lg_b, s_b)
    gate = jax.nn.silu(to_heads(lr_g, C_HEADS, HEAD_DIM))
    out_r = (rms_norm(o_f + flip(o_b), p['c_gn_g']) * gate).astype(x.dtype)
    if need_ctx:
        gate_c = jax.nn.silu(to_heads(cr_g, C_HEADS, HEAD_DIM))
        cout_r = (rms_norm(o_cf + flip(o_cb), p['c_gn_g']) * gate_c).astype(x.dtype)

    q = rms_norm(to_heads(ln_q, D_HEADS, HEAD_DIM), p['d_qnorm_g'])
    k = rms_norm(to_heads(ln_k, D_HEADS, HEAD_DIM), p['d_knorm_g'])
    v = to_heads(ln_v, D_HEADS, HEAD_DIM)
    k_c = rms_norm(to_heads(cn_k, D_HEADS, HEAD_DIM), p['d_knorm_g'])
    v_c = to_heads(cn_v, D_HEADS, HEAD_DIM)
    out_n = neighbourhood_attention(q, k, v, k_c, v_c, p['d_rpb'])
    if need_ctx:
        q_c = rms_norm(to_heads(cn_q, D_HEADS, HEAD_DIM), p['d_qnorm_g'])
        cout_n = dense_ctx_attention(q_c, k_c, v_c)

    mix_x = jnp.concatenate([from_heads(out_w), from_heads(out_f), from_heads(out_r), from_heads(out_n)], axis=-1) @ p['w_out']
    x = x + (g1x * mix_x).astype(x.dtype)
    h2 = rms_norm(x, p['norm2_g']) * (1 + sc2x) + sh2x
    x = x + (g2x * squared_relu_mlp(h2, p['w_mlp1'], p['w_mlp2'])).astype(x.dtype)

    if need_ctx:
        mix_c = jnp.concatenate([from_heads(cout_w), from_heads(cout_f), from_heads(cout_r), from_heads(cout_n)], axis=-1) @ p['w_out']
        ctx = ctx + (g1c * mix_c).astype(ctx.dtype)
        h2c = rms_norm(ctx, p['norm2_g']) * (1 + sc2c) + sh2c
        ctx = ctx + (g2c * squared_relu_mlp(h2c, p['w_mlp1'], p['w_mlp2'])).astype(ctx.dtype)
    return x, ctx


def setup_inputs(seed: int = 0) -> dict:
    key = jax.random.key(seed)
    ks = iter(jax.random.split(key, 32))
    f32 = jnp.float32

    def nrm(shape, scale):
        return jax.random.normal(next(ks), shape, f32) * scale

    def gain(shape):
        return 1.0 + 0.05 * jax.random.normal(next(ks), shape, f32)

    decay_base = jnp.log(2.0 ** (5.0 + jnp.arange(C_HEADS, dtype=f32)) - 1.0)
    return {
        'x': nrm((BATCH, SEQ, D_MODEL), 1.0),
        'c': nrm((BATCH, D_MODEL), 1.0),
        'ctx': nrm((BATCH, CTX_LEN, D_MODEL), 1.0),
        'c_ctx': nrm((D_MODEL,), 1.0),
        'w_mod': nrm((DEPTH, D_MODEL, 6 * D_MODEL), 0.5 * D_MODEL ** -0.5),
        'b_mod': nrm((DEPTH, 6 * D_MODEL), 0.02),
        'norm1_g': gain((DEPTH, D_MODEL)),
        'norm2_g': gain((DEPTH, D_MODEL)),
        'w_in': nrm((DEPTH, D_MODEL, IN_WIDTH), D_MODEL ** -0.5),
        'w_out': nrm((DEPTH, N_MIXERS * GROUP_WIDTH, D_MODEL), (N_MIXERS * GROUP_WIDTH) ** -0.5),
        'a_qnorm_g': gain((DEPTH, HEAD_DIM)),
        'a_knorm_g': gain((DEPTH, HEAD_DIM)),
        'a_sink': nrm((DEPTH, A_HEADS), 0.5),
        'b_qnorm_g': gain((DEPTH, B_QK_DIM)),
        'b_knorm_g': gain((DEPTH, B_QK_DIM)),
        'b_lambda_q1': nrm((DEPTH, B_QK_DIM), 0.1),
        'b_lambda_k1': nrm((DEPTH, B_QK_DIM), 0.1),
        'b_lambda_q2': nrm((DEPTH, B_QK_DIM), 0.1),
        'b_lambda_k2': nrm((DEPTH, B_QK_DIM), 0.1),
        'b_subln_g': gain((DEPTH, HEAD_DIM)),
        'c_decay_fwd': decay_base[None, :] + nrm((DEPTH, C_HEADS), 0.1),
        'c_decay_bwd': decay_base[None, :] + nrm((DEPTH, C_HEADS), 0.1),
        'c_gn_g': gain((DEPTH, HEAD_DIM)),
        'd_qnorm_g': gain((DEPTH, HEAD_DIM)),
        'd_knorm_g': gain((DEPTH, HEAD_DIM)),
        'd_rpb': nrm((DEPTH, D_HEADS, 2 * NA_ROWS - 1, 2 * NA_COLS - 1), 0.1),
        'w_mlp1': nrm((DEPTH, D_MODEL, D_FF), D_MODEL ** -0.5),
        'w_mlp2': nrm((DEPTH, D_FF, D_MODEL), D_FF ** -0.5),
    }


def reference(x, c, ctx, c_ctx, w_mod, b_mod, norm1_g, norm2_g, w_in, w_out,
              a_qnorm_g, a_knorm_g, a_sink, b_qnorm_g, b_knorm_g,
              b_lambda_q1, b_lambda_k1, b_lambda_q2, b_lambda_k2, b_subln_g,
              c_decay_fwd, c_decay_bwd, c_gn_g, d_qnorm_g, d_knorm_g, d_rpb,
              w_mlp1, w_mlp2):
    for layer in range(DEPTH):
        p = {
            'w_mod': w_mod[layer], 'b_mod': b_mod[layer],
            'norm1_g': norm1_g[layer], 'norm2_g': norm2_g[layer],
            'w_in': w_in[layer], 'w_out': w_out[layer],
            'a_qnorm_g': a_qnorm_g[layer], 'a_knorm_g': a_knorm_g[layer], 'a_sink': a_sink[layer],
            'b_qnorm_g': b_qnorm_g[layer], 'b_knorm_g': b_knorm_g[layer],
            'b_lambda_q1': b_lambda_q1[layer], 'b_lambda_k1': b_lambda_k1[layer],
            'b_lambda_q2': b_lambda_q2[layer], 'b_lambda_k2': b_lambda_k2[layer],
            'b_subln_g': b_subln_g[layer],
            'c_decay_fwd': c_decay_fwd[layer], 'c_decay_bwd': c_decay_bwd[layer], 'c_gn_g': c_gn_g[layer],
            'd_qnorm_g': d_qnorm_g[layer], 'd_knorm_g': d_knorm_g[layer], 'd_rpb': d_rpb[layer],
            'w_mlp1': w_mlp1[layer], 'w_mlp2': w_mlp2[layer],
        }
        x, ctx = hybrid_layer(x, ctx, c, c_ctx, p, layer, layer < DEPTH - 1)
    return x
```

```cpp
#include <hip/hip_runtime.h>
#include <hip/hip_cooperative_groups.h>
#include <cstdio>
#include <cstdint>
namespace cg = cooperative_groups;
#ifndef PROBE_DUP
#define PROBE_DUP 0
#endif

#define DI __device__ __forceinline__
#define LAS __attribute__((address_space(3)))
typedef short bf16x8 __attribute__((ext_vector_type(8)));
typedef float f32x16 __attribute__((ext_vector_type(16)));
typedef float f32x4 __attribute__((ext_vector_type(4)));
typedef float f32x2 __attribute__((ext_vector_type(2)));
typedef unsigned u32x4 __attribute__((ext_vector_type(4)));
typedef unsigned u32x2 __attribute__((ext_vector_type(2)));
typedef __bf16 bf16x2_t __attribute__((ext_vector_type(2)));
typedef unsigned short bf16_t;

constexpr int NB = 4, SEQ = 4096, CTX = 256, T = SEQ + CTX, M = NB * T, D = 1024, DFF = 4096, NIN = 3072, NGRP = 18;
constexpr float EPS = 1e-6f, LOG2E = 1.4426950408889634f;

constexpr size_t WS_BAR = 0;
constexpr size_t WS_TAB = 16384;
constexpr size_t WS_MOD = 65536;
constexpr size_t WS_CTXB = 327680;
constexpr size_t WS_W = WS_CTXB + 4194304;
constexpr size_t W_IN_OFF = 0, W_OUT_OFF = 6291456, W_1_OFF = 8388608, W_2_OFF = 16777216;
constexpr size_t WS_ACT = WS_W + 25165824;
constexpr size_t WS_KV = WS_ACT + 35651584;
constexpr size_t WS_SIN = WS_KV + 17825792;
constexpr size_t WS_QKV = WS_SIN + 8912896;
constexpr size_t WS_VT = WS_QKV + 106954752;
constexpr size_t WS_KFB = WS_VT + 40108032;
constexpr size_t WS_KG8 = WS_KFB + 8912896;
constexpr size_t WS_END = WS_KG8 + 13369344;

constexpr int LDS_PITCH = 80, STAGE_MAT = 256 * LDS_PITCH, LDS_MAIN = 128 * 260 * 4, LDS_BYTES = LDS_MAIN + 256;

struct Params { const float* in[28]; float* out; unsigned char* ws; };

DI unsigned pk2(float a, float b) { f32x2 v = {a, b}; bf16x2_t r = __builtin_convertvector(v, bf16x2_t); return __builtin_bit_cast(unsigned, r); }
DI bf16x8 pack8(float a0, float a1, float a2, float a3, float a4, float a5, float a6, float a7) {
    u32x4 p = {pk2(a0, a1), pk2(a2, a3), pk2(a4, a5), pk2(a6, a7)}; return __builtin_bit_cast(bf16x8, p);
}
DI f32x16 mfma(bf16x8 a, bf16x8 b, f32x16 c) { return __builtin_amdgcn_mfma_f32_32x32x16_bf16(a, b, c, 0, 0, 0); }
DI f32x16 zero16() { f32x16 z; for (int i = 0; i < 16; ++i) z[i] = 0.f; return z; }
DI float ex2(float x) { return __builtin_amdgcn_exp2f(x); }
DI bf16x8 ldg8(const bf16_t* p) { return *(const bf16x8*)p; }
DI int crow(int i, int h) { return (i & 3) + 8 * (i >> 2) + 4 * h; }
DI int keyperm(int r) { const int a = r >> 3, g = (r >> 2) & 1, c = r & 3; return (a >> 1) * 16 + g * 8 + (a & 1) * 4 + c; }
DI int kidx(int i, int h) { return (i >> 3) * 16 + h * 8 + (i & 7); }
DI float bf2f(unsigned short u) { return __uint_as_float(((unsigned)u) << 16); }
DI int otid() { int t = threadIdx.x; asm volatile("" : "+v"(t)); return t; }
DI void stwt16(void* p, bf16x8 v) { asm volatile("global_store_dwordx4 %0, %1, off sc1\n\ts_nop 1" :: "v"(p), "v"(v) : "memory"); }
DI float wave_sum(float v) { for (int o = 32; o > 0; o >>= 1) v += __shfl_xor(v, o); return v; }

#define XB_TMO      128
#define XB_XCNT(j)  (256  + 64 * (j))
#define XB_XSUB(j)  (1280 + 64 * (j))
#define XB_XGEN(j)  (2304 + 64 * (j))
#define XB_TOP      3328
#define XB_TOPGEN   3392
#define XCD_BAR_WORDS 3456
#define XB_SPIN_CAP (1u << 22)
DI unsigned xb_ld(unsigned* p) { return __hip_atomic_load(p, __ATOMIC_RELAXED, __HIP_MEMORY_SCOPE_AGENT); }
DI unsigned xb_add(unsigned* p, unsigned v) { return __hip_atomic_fetch_add(p, v, __ATOMIC_RELAXED, __HIP_MEMORY_SCOPE_AGENT); }
DI unsigned xb_xcc_id() { return (unsigned)__builtin_amdgcn_s_getreg((3 << 11) | 20) & 0xFu; }
#define XB_SPIN(cond, bar) do { unsigned _sp = 0; while (cond) { __builtin_amdgcn_s_sleep(1); \
    if ((++_sp & 255u) == 0u) { if (xb_ld(&(bar)[XB_TMO])) break; if (_sp > XB_SPIN_CAP) { atomicAdd(&(bar)[XB_TMO], 1u); break; } } } } while (0)
struct XcdBarrier { unsigned* bar; unsigned x; volatile LAS unsigned* st; };
DI XcdBarrier xcd_barrier_post(unsigned* bar, volatile LAS unsigned* st) {
    XcdBarrier b; b.bar = bar; b.x = xb_xcc_id(); b.st = st;
    if (threadIdx.x == 0) (void)xb_add(&bar[XB_XCNT(b.x)], 1u);
    return b;
}
DI void xcd_barrier_complete(unsigned* bar, unsigned x, unsigned& nloc, unsigned& nx) {
    const unsigned G = gridDim.x * gridDim.y * gridDim.z;
    unsigned sum, cnt, mine, sp = 0u;
    for (;;) {
        sum = 0u; cnt = 0u; mine = 0u;
#pragma unroll
        for (unsigned j = 0; j < 16; ++j) { const unsigned c = xb_ld(&bar[XB_XCNT(j)]); sum += c; cnt += (c > 0u) ? 1u : 0u; mine = (j == x) ? c : mine; }
        if (sum == G) break;
        __builtin_amdgcn_s_sleep(1);
        if ((++sp & 255u) == 0u) { if (xb_ld(&bar[XB_TMO])) break; if (sp > XB_SPIN_CAP) { atomicAdd(&bar[XB_TMO], 1u); break; } }
    }
    nloc = mine > 0u ? mine : 1u; nx = cnt > 0u ? cnt : 1u;
}
DI void xcd_barrier(const XcdBarrier& b) {
    asm volatile("s_waitcnt vmcnt(0)" ::: "memory");
    __syncthreads();
    if (threadIdx.x == 0) {
        unsigned* bar = b.bar;
        __builtin_amdgcn_s_waitcnt(0);
        unsigned nloc = b.st[0], nx = b.st[1];
        const unsigned old = xb_add(&bar[XB_XSUB(b.x)], 1u);
        const unsigned gen = old / nloc;
        if (old + 1u == (gen + 1u) * nloc) {
            __builtin_amdgcn_fence(__ATOMIC_RELEASE, "agent");
            asm volatile("s_waitcnt vmcnt(0)" ::: "memory");
            const unsigned og = xb_add(&bar[XB_TOP], 1u);
            const unsigned tg = og / nx;
            if (og + 1u == (tg + 1u) * nx) {
                xb_add(&bar[XB_TOPGEN], 1u);
                xb_add(&bar[XB_XGEN(b.x)], 1u);
                __builtin_amdgcn_fence(__ATOMIC_ACQUIRE, "agent");
                asm volatile("s_waitcnt vmcnt(0)" ::: "memory");
            } else {
                __builtin_amdgcn_fence(__ATOMIC_ACQUIRE, "agent");
                asm volatile("s_waitcnt vmcnt(0)" ::: "memory");
                XB_SPIN(xb_ld(&bar[XB_TOPGEN]) == tg, bar);
                xb_add(&bar[XB_XGEN(b.x)], 1u);
            }
        } else {
            __builtin_amdgcn_fence(__ATOMIC_ACQUIRE, "agent");
            asm volatile("s_waitcnt vmcnt(0)" ::: "memory");
            XB_SPIN(xb_ld(&bar[XB_XGEN(b.x)]) == gen, bar);
        }
    }
    __syncthreads();
}

DI void sincos_acc(float xf, float& s, float& c) {
    const double x = (double)xf;
    const double n = rint(x * 0.6366197723675814);
    const double rr = x - n * 1.5707963267948966;
    const double r2 = rr * rr;
    const double sp = rr * (1.0 + r2 * (-1.0 / 6 + r2 * (1.0 / 120 + r2 * (-1.0 / 5040 + r2 * (1.0 / 362880 + r2 * (-1.0 / 39916800 + r2 * (1.0 / 6227020800.0)))))));
    const double cp = 1.0 + r2 * (-0.5 + r2 * (1.0 / 24 + r2 * (-1.0 / 720 + r2 * (1.0 / 40320 + r2 * (-1.0 / 3628800 + r2 * (1.0 / 479001600 + r2 * (-1.0 / 87178291200.0)))))));
    const int q = ((int)n) & 3;
    const double ss = (q == 0) ? sp : (q == 1) ? cp : (q == 2) ? -sp : -cp;
    const double cc = (q == 0) ? cp : (q == 1) ? -sp : (q == 2) ? -cp : sp;
    s = (float)ss; c = (float)cc;
}

__device__ void prep_tables(const Params& p) {
    float* tab = (float*)(p.ws + WS_TAB);
    const int tid = otid();
    for (int idx = tid; idx < 1536; idx += 512) {
        int pos, i; float freq;
        if (idx < 1024) { pos = idx >> 4; i = idx & 15; freq = exp2f(-(float)i * (13.287712379549449f / 16.f)); }
        else { const int j = idx - 1024; pos = j >> 3; i = j & 7; freq = exp2f(-(float)i * (13.287712379549449f / 8.f)); }
        const float ang = (float)pos * freq;
        float s, c; sincos_acc(ang, s, c);
        if (idx < 1024) { tab[idx] = c; tab[1024 + idx] = s; }
        else { tab[2048 + (idx - 1024)] = c; tab[2560 + (idx - 1024)] = s; }
    }
    if (tid < 128) {
        const int l = tid >> 6, lane = tid & 63;
        float* cst = tab + 3072 + l * 32;
        float s1 = 0.f, s2 = 0.f;
        if (lane < 32) { s1 = p.in[15][l * 32 + lane] * p.in[16][l * 32 + lane]; s2 = p.in[17][l * 32 + lane] * p.in[18][l * 32 + lane]; }
        s1 = wave_sum(s1); s2 = wave_sum(s2);
        float maq = fabsf(p.in[10][l * 64 + lane]), mak = fabsf(p.in[11][l * 64 + lane]), mdq = fabsf(p.in[23][l * 64 + lane]), mdk = fabsf(p.in[24][l * 64 + lane]);
        float mbq = fabsf(p.in[13][l * 32 + (lane & 31)]), mbk = fabsf(p.in[14][l * 32 + (lane & 31)]);
        float mr = 0.f;
        for (int i = lane; i < 4 * 465; i += 64) mr = fmaxf(mr, fabsf(p.in[25][l * 1860 + i]));
        for (int o = 32; o > 0; o >>= 1) {
            maq = fmaxf(maq, __shfl_xor(maq, o)); mak = fmaxf(mak, __shfl_xor(mak, o)); mdq = fmaxf(mdq, __shfl_xor(mdq, o)); mdk = fmaxf(mdk, __shfl_xor(mdk, o));
            mbq = fmaxf(mbq, __shfl_xor(mbq, o)); mbk = fmaxf(mbk, __shfl_xor(mbk, o)); mr = fmaxf(mr, __shfl_xor(mr, o));
        }
        if (lane == 0) {
            const float li = 0.8f - 0.6f * expf(-0.3f * (float)l);
            cst[0] = expf(s1) - expf(s2) + li;
            cst[1] = 1.f - li;
            cst[2] = 8.f * maq * mak * LOG2E;
            cst[3] = 5.656854249492381f * mbq * mbk * LOG2E;
            cst[4] = (8.f * mdq * mdk + mr) * LOG2E;
        }
        if (lane < 4) {
            cst[8 + lane] = -log1pf(expf(-p.in[20][l * 4 + lane])) * LOG2E;
            cst[12 + lane] = -log1pf(expf(-p.in[21][l * 4 + lane])) * LOG2E;
            cst[16 + lane] = p.in[12][l * 4 + lane] * LOG2E;
        }
    }
}

__device__ void mod_item(const Params& p, int item, unsigned char* lds) {
    float* sv = (float*)lds;
    float* red = sv + 5 * 1024;
    const int tid = otid(), l = item / 96, n0 = (item % 96) * 64;
    for (int idx = tid; idx < 5 * 1024; idx += 512) {
        const int j = idx >> 10, k = idx & 1023;
        const float c = (j < 4) ? p.in[1][j * 1024 + k] : p.in[3][k];
        sv[idx] = c / (1.f + expf(-c));
    }
    __syncthreads();
    const int col = tid & 63, kg = tid >> 6;
    const float* w = p.in[4] + (size_t)l * 1024 * 6144 + (size_t)(kg * 128) * 6144 + n0 + col;
    float a0 = 0.f, a1 = 0.f, a2 = 0.f, a3 = 0.f, a4 = 0.f;
#pragma unroll 16
    for (int k = 0; k < 128; ++k) {
        const float wv = w[(size_t)k * 6144];
        const int kk = kg * 128 + k;
        a0 += sv[kk] * wv; a1 += sv[1024 + kk] * wv; a2 += sv[2048 + kk] * wv; a3 += sv[3072 + kk] * wv; a4 += sv[4096 + kk] * wv;
    }
    red[(kg * 5 + 0) * 64 + col] = a0; red[(kg * 5 + 1) * 64 + col] = a1; red[(kg * 5 + 2) * 64 + col] = a2;
    red[(kg * 5 + 3) * 64 + col] = a3; red[(kg * 5 + 4) * 64 + col] = a4;
    __syncthreads();
    if (tid < 320) {
        const int j = tid >> 6, c = tid & 63;
        float s = p.in[5][l * 6144 + n0 + c];
        for (int g = 0; g < 8; ++g) s += red[(g * 5 + j) * 64 + c];
        ((float*)(p.ws + WS_MOD))[(l * 5 + j) * 6144 + n0 + c] = s;
    }
    __syncthreads();
}

__device__ void conv_layer(const Params& p, int l, unsigned char* lds, int lo, int hi, int bfirst, int nblk) {
    const int tid = otid(), grp = tid >> 7, t = tid & 127;
    float* tl = (float*)lds + grp * (64 * 65);
    bf16_t* wb = (bf16_t*)(p.ws + WS_W);
    if ((int)blockIdx.x < bfirst || (int)blockIdx.x >= bfirst + nblk) return;
    for (int it0 = lo + ((int)blockIdx.x - bfirst) * 4; it0 < hi; it0 += nblk * 4) {
        const int it = it0 + grp;
        const float* W; bf16_t* WT; int K, N, tile;
        if (it < 768) { W = p.in[8] + (size_t)l * 1024 * 3072; WT = (bf16_t*)((unsigned char*)wb + W_IN_OFF); K = 1024; N = 3072; tile = it; }
        else if (it < 1024) { W = p.in[9] + (size_t)l * 1024 * 1024; WT = (bf16_t*)((unsigned char*)wb + W_OUT_OFF); K = 1024; N = 1024; tile = it - 768; }
        else if (it < 2048) { W = p.in[26] + (size_t)l * 1024 * 4096; WT = (bf16_t*)((unsigned char*)wb + W_1_OFF); K = 1024; N = 4096; tile = it - 1024; }
        else { W = p.in[27] + (size_t)l * 4096 * 1024; WT = (bf16_t*)((unsigned char*)wb + W_2_OFF); K = 4096; N = 1024; tile = it - 2048; }
        const int nkt = K / 64, kt = tile % nkt, nt = tile / nkt, k0 = kt * 64, n0 = nt * 64;
        f32x4 v[8];
#pragma unroll
        for (int i = 0; i < 8; ++i) { const int idx = t + i * 128, k = idx >> 4, c4 = idx & 15; v[i] = *(const f32x4*)(W + (size_t)(k0 + k) * N + n0 + c4 * 4); }
#pragma unroll
        for (int i = 0; i < 8; ++i) { const int idx = t + i * 128, k = idx >> 4, c4 = idx & 15;
            tl[k * 65 + c4 * 4 + 0] = v[i][0]; tl[k * 65 + c4 * 4 + 1] = v[i][1]; tl[k * 65 + c4 * 4 + 2] = v[i][2]; tl[k * 65 + c4 * 4 + 3] = v[i][3]; }
        __syncthreads();
#pragma unroll
        for (int i = 0; i < 4; ++i) {
            const int idx = t + i * 128, n = idx >> 3, kc = idx & 7;
            float w[8];
#pragma unroll
            for (int j = 0; j < 8; ++j) w[j] = tl[(kc * 8 + j) * 65 + n];
            *(bf16x8*)(WT + (size_t)(n0 + n) * K + k0 + kc * 8) = pack8(w[0], w[1], w[2], w[3], w[4], w[5], w[6], w[7]);
        }
        __syncthreads();
    }
}

__device__ void norm_phase(const float* lat, const float* ctxb, const float* g, const float* mod, int shoff, int scoff, bf16_t* act, bool skip_ctx,
                           const float* slab = nullptr, int nsplit = 0, const float* gatec = nullptr, float* ctx_wb = nullptr, const float* slab2 = nullptr) {
    const int tid = otid(), lane = tid & 63, gw = blockIdx.x * 8 + (tid >> 6), nw = gridDim.x * 8;
    f32x4 gg[4], sh[4], sc[4], v[4], nx[4];
#pragma unroll
    for (int i = 0; i < 4; ++i) gg[i] = *(const f32x4*)(g + i * 256 + lane * 4);
    if (!skip_ctx) {
        const float* mj = mod + 4 * 6144;
        bool have = false;
        for (int cr = gw; cr < NB * CTX; cr += nw) {
            const int b = cr >> 8, t = cr & 255, R = b * T + t;
            if (!have) {
                have = true;
#pragma unroll
                for (int i = 0; i < 4; ++i) { sh[i] = *(const f32x4*)(mj + shoff + i * 256 + lane * 4); sc[i] = *(const f32x4*)(mj + scoff + i * 256 + lane * 4); }
            }
#pragma unroll
            for (int i = 0; i < 4; ++i) v[i] = *(const f32x4*)(ctxb + (size_t)cr * D + i * 256 + lane * 4);
            if (nsplit > 0) {
#pragma unroll
                for (int i = 0; i < 4; ++i) {
                    f32x4 acc = {0.f, 0.f, 0.f, 0.f};
                    for (int sp = 0; sp < nsplit; ++sp) { const f32x4 pv = *(const f32x4*)((sp < 4 ? slab : slab2) + ((size_t)(((sp & 3) * 16 + b * 4 + i) * 256 + t)) * 256 + lane * 4); acc += pv; }
                    const f32x4 gt = *(const f32x4*)(gatec + i * 256 + lane * 4);
                    v[i] += gt * acc;
                    if (ctx_wb) *(f32x4*)(ctx_wb + (size_t)cr * D + i * 256 + lane * 4) = v[i];
                }
            }
            float ss = 0.f;
#pragma unroll
            for (int i = 0; i < 4; ++i) ss += v[i][0] * v[i][0] + v[i][1] * v[i][1] + v[i][2] * v[i][2] + v[i][3] * v[i][3];
            ss = wave_sum(ss);
            const float rstd = rsqrtf(ss * (1.f / 1024.f) + EPS);
#pragma unroll
            for (int i = 0; i < 4; ++i) {
                float y[4];
#pragma unroll
                for (int e = 0; e < 4; ++e) y[e] = v[i][e] * rstd * gg[i][e] * (1.f + sc[i][e]) + sh[i][e];
                u32x2 o = {pk2(y[0], y[1]), pk2(y[2], y[3])};
                *(u32x2*)(act + (size_t)R * D + i * 256 + lane * 4) = o;
            }
        }
    }
    const int per = (NB * SEQ + nw - 1) / nw;
    int Rl = gw * per; const int Rend = min(NB * SEQ, Rl + per);
    if (Rl >= Rend) return;
    int curb = -1;
#pragma unroll
    for (int i = 0; i < 4; ++i) v[i] = *(const f32x4*)(lat + (size_t)Rl * D + i * 256 + lane * 4);
    for (; Rl < Rend; ++Rl) {
        if (Rl + 1 < Rend) {
#pragma unroll
            for (int i = 0; i < 4; ++i) nx[i] = *(const f32x4*)(lat + (size_t)(Rl + 1) * D + i * 256 + lane * 4);
        }
        const int b = Rl >> 12, R = b * T + CTX + (Rl & 4095);
        if (b != curb) {
            curb = b;
            const float* mj = mod + b * 6144;
#pragma unroll
            for (int i = 0; i < 4; ++i) { sh[i] = *(const f32x4*)(mj + shoff + i * 256 + lane * 4); sc[i] = *(const f32x4*)(mj + scoff + i * 256 + lane * 4); }
        }
        float ss = 0.f;
#pragma unroll
        for (int i = 0; i < 4; ++i) ss += v[i][0] * v[i][0] + v[i][1] * v[i][1] + v[i][2] * v[i][2] + v[i][3] * v[i][3];
        ss = wave_sum(ss);
        const float rstd = rsqrtf(ss * (1.f / 1024.f) + EPS);
#pragma unroll
        for (int i = 0; i < 4; ++i) {
            float y[4];
#pragma unroll
            for (int e = 0; e < 4; ++e) y[e] = v[i][e] * rstd * gg[i][e] * (1.f + sc[i][e]) + sh[i][e];
            u32x2 o = {pk2(y[0], y[1]), pk2(y[2], y[3])};
            *(u32x2*)(act + (size_t)R * D + i * 256 + lane * 4) = o;
        }
#pragma unroll
        for (int i = 0; i < 4; ++i) v[i] = nx[i];
    }
}

struct EpiArgs {
    const float* lat_in; const float* ctx_in; float* lat_out; float* ctx_out; const float* gate;
    bf16_t* out; int ldo;
    bf16_t* vt; bf16_t* kfb; bf16_t* kg8; unsigned* kvcnt; const float* aq; const float* ak; const float* bq; const float* bk; const float* dq; const float* dk; const float* tab;
};
enum { EPI_RESID = 0, EPI_RELU2 = 1, EPI_INPROJ = 2 };

DI void inproj_slab(const EpiArgs& ea, int cgi, const float* st, int Rbase, int lane) {
    int kind; const float* g = nullptr; float scale = 1.f; int vt_grp = -1;
    if (cgi < 4) { kind = 0; g = ea.aq; scale = 0.125f * LOG2E; }
    else if (cgi < 6) { kind = 0; g = ea.ak; }
    else if (cgi < 8) { kind = 5; vt_grp = cgi - 6; }
    else if (cgi < 12) { kind = 1; g = ea.bq; scale = 0.17677669529663687f * LOG2E; }
    else if (cgi < 16) { kind = 1; g = ea.bk; }
    else if (cgi < 20) { kind = 5; vt_grp = 2 + cgi - 16; }
    else if (cgi < 24) { kind = 3; }
    else if (cgi < 28) { kind = 3; scale = 0.125f; vt_grp = 14 + cgi - 24; }
    else if (cgi < 32) { kind = 5; vt_grp = 6 + cgi - 28; }
    else if (cgi < 36) { kind = 4; }
    else if (cgi < 40) { kind = 2; g = ea.dq; scale = 0.125f * LOG2E; }
    else if (cgi < 44) { kind = 2; g = ea.dk; }
    else { kind = 5; vt_grp = 10 + cgi - 44; }

    if (kind != 5) {
        const int row = lane >> 1, half = lane & 1, R = Rbase + row, b = R / T, t = R - b * T;
        const bool lat = t >= CTX; const int pos = t - CTX, pr = pos >> 6, pc = pos & 63;
        float v[32];
#pragma unroll
        for (int j = 0; j < 8; ++j) { const f32x4 q = *(const f32x4*)(st + row * 68 + half * 32 + j * 4); v[4 * j] = q[0]; v[4 * j + 1] = q[1]; v[4 * j + 2] = q[2]; v[4 * j + 3] = q[3]; }
        if (kind == 0 || kind == 2) {
            float ss = 0.f;
#pragma unroll
            for (int i = 0; i < 32; ++i) ss += v[i] * v[i];
            ss += __shfl_xor(ss, 1);
            const float rstd = rsqrtf(ss * (1.f / 64.f) + EPS);
#pragma unroll
            for (int i = 0; i < 32; ++i) v[i] *= rstd * g[half * 32 + i];
            if (kind == 0 && lat) {
                const int pp = half ? pc : pr;
                const float* tc = ea.tab + pp * 16; const float* ts = ea.tab + 1024 + pp * 16;
#pragma unroll
                for (int i = 0; i < 16; ++i) { const float c = tc[i], s = ts[i], x1 = v[i], x2 = v[i + 16]; v[i] = x1 * c - x2 * s; v[i + 16] = x1 * s + x2 * c; }
            }
        } else if (kind == 1) {
            float ss = 0.f;
#pragma unroll
            for (int i = 0; i < 32; ++i) ss += v[i] * v[i];
            const float rstd = rsqrtf(ss * (1.f / 32.f) + EPS);
#pragma unroll
            for (int i = 0; i < 32; ++i) v[i] *= rstd * g[i];
            if (lat) {
                const float* tcr = ea.tab + 2048 + pr * 8; const float* tsr = ea.tab + 2560 + pr * 8;
                const float* tcc = ea.tab + 2048 + pc * 8; const float* tsc = ea.tab + 2560 + pc * 8;
#pragma unroll
                for (int i = 0; i < 8; ++i) {
                    { const float c = tcr[i], s = tsr[i], x1 = v[i], x2 = v[i + 8]; v[i] = x1 * c - x2 * s; v[i + 8] = x1 * s + x2 * c; }
                    { const float c = tcc[i], s = tsc[i], x1 = v[16 + i], x2 = v[24 + i]; v[16 + i] = x1 * c - x2 * s; v[24 + i] = x1 * s + x2 * c; }
                }
            }
        } else if (kind == 4) {
#pragma unroll
            for (int i = 0; i < 32; ++i) v[i] = v[i] / (1.f + __expf(-v[i]));
        }
        bf16_t* dst = ea.out + (size_t)R * NIN + cgi * 64 + half * 32;
#pragma unroll
        for (int j = 0; j < 4; ++j)
            *(bf16x8*)(dst + j * 8) = pack8(v[8 * j] * scale, v[8 * j + 1] * scale, v[8 * j + 2] * scale, v[8 * j + 3] * scale, v[8 * j + 4] * scale, v[8 * j + 5] * scale, v[8 * j + 6] * scale, v[8 * j + 7] * scale);
    }
    if (vt_grp >= 0) {
        const int b = Rbase / T, t0 = Rbase - b * T;
        float v[32];
#pragma unroll
        for (int rr = 0; rr < 32; ++rr) v[rr] = st[rr * 68 + lane] * scale;
        bf16_t* dst = ea.vt + ((size_t)(b * NGRP + vt_grp) * 64 + lane) * T + t0;
#pragma unroll
        for (int j = 0; j < 4; ++j)
            *(bf16x8*)(dst + j * 8) = pack8(v[8 * j], v[8 * j + 1], v[8 * j + 2], v[8 * j + 3], v[8 * j + 4], v[8 * j + 5], v[8 * j + 6], v[8 * j + 7]);
    }
}

template <int EPI>
__device__ void gemm_phase(const bf16_t* __restrict__ A, const bf16_t* __restrict__ Bt, int K, int N, const EpiArgs& ea, unsigned char* lds, bool skip_ctx) {
    const int tid = otid(), wid = tid >> 6, lane = tid & 63, r = lane & 31, h = lane >> 5, wr = wid >> 2, wc = wid & 3;
    const int nN = N / 256, ntiles = 68 * nN, nk = K / 32;
    const int lrow = tid >> 2, lkc = tid & 3;
    for (int tile = blockIdx.x; tile < ntiles; tile += gridDim.x) {
        const int pm = tile % 68, pn = tile / 68;
        if (skip_ctx && (pm % 17 == 0)) continue;
        const int m0 = pm * 256, n0 = pn * 256;
        f32x16 acc[4][2];
#pragma unroll
        for (int i = 0; i < 4; ++i) { acc[i][0] = zero16(); acc[i][1] = zero16(); }
        const bf16_t* ga = A + (size_t)(m0 + lrow) * K + lkc * 8;
        const bf16_t* gb = Bt + (size_t)(n0 + lrow) * K + lkc * 8;
        const int loff = lrow * LDS_PITCH + lkc * 16;
        u32x4 ra[2], rb[2];
#pragma unroll
        for (int i = 0; i < 2; ++i) { ra[i] = *(const u32x4*)(ga + (size_t)i * 128 * K); rb[i] = *(const u32x4*)(gb + (size_t)i * 128 * K); }
#pragma unroll
        for (int i = 0; i < 2; ++i) { *(u32x4*)(lds + loff + i * 128 * LDS_PITCH) = ra[i]; *(u32x4*)(lds + STAGE_MAT + loff + i * 128 * LDS_PITCH) = rb[i]; }
        __syncthreads();
#pragma unroll
        for (int i = 0; i < 2; ++i) { ra[i] = *(const u32x4*)(ga + (size_t)i * 128 * K + 32); rb[i] = *(const u32x4*)(gb + (size_t)i * 128 * K + 32); }
#pragma unroll 1
        for (int kt = 0; kt < nk; ++kt) {
            const unsigned char* sa = lds + (kt & 1) * 2 * STAGE_MAT;
            const unsigned char* sb = sa + STAGE_MAT;
#pragma unroll
            for (int ks = 0; ks < 2; ++ks) {
                bf16x8 af[4], bfr[2];
#pragma unroll
                for (int mb = 0; mb < 4; ++mb) af[mb] = *(const bf16x8*)(sa + (wr * 128 + mb * 32 + r) * LDS_PITCH + ks * 32 + h * 16);
#pragma unroll
                for (int nb = 0; nb < 2; ++nb) bfr[nb] = *(const bf16x8*)(sb + (wc * 64 + nb * 32 + r) * LDS_PITCH + ks * 32 + h * 16);
#pragma unroll
                for (int mb = 0; mb < 4; ++mb)
#pragma unroll
                    for (int nb = 0; nb < 2; ++nb) acc[mb][nb] = mfma(af[mb], bfr[nb], acc[mb][nb]);
            }
            if (kt + 1 < nk) {
                unsigned char* da = lds + ((kt + 1) & 1) * 2 * STAGE_MAT;
#pragma unroll
                for (int i = 0; i < 2; ++i) { *(u32x4*)(da + loff + i * 128 * LDS_PITCH) = ra[i]; *(u32x4*)(da + STAGE_MAT + loff + i * 128 * LDS_PITCH) = rb[i]; }
            }
            __syncthreads();
            if (kt + 2 < nk) {
#pragma unroll
                for (int i = 0; i < 2; ++i) { ra[i] = *(const u32x4*)(ga + (size_t)i * 128 * K + (kt + 2) * 32); rb[i] = *(const u32x4*)(gb + (size_t)i * 128 * K + (kt + 2) * 32); }
            }
        }
        {
            float* st = (float*)(lds + wid * 8704);
            const int cgi = (n0 + wc * 64) >> 6;
#pragma unroll
            for (int mb = 0; mb < 4; ++mb) {
                __syncthreads();
#pragma unroll
                for (int nb = 0; nb < 2; ++nb)
#pragma unroll
                    for (int i = 0; i < 16; ++i) st[crow(i, h) * 68 + nb * 32 + r] = acc[mb][nb][i];
                __syncthreads();
                const int Rbase = m0 + wr * 128 + mb * 32;
                if (EPI == EPI_INPROJ) inproj_slab(ea, cgi, st, Rbase, lane);
                else if (EPI == EPI_RESID) {
                    const int row = lane >> 1, half = lane & 1;
                    const int b = pm / 17, tt = pm % 17;
                    const float* gate = ea.gate + ((tt == 0) ? 4 : b) * 6144 + n0 + wc * 64 + half * 32;
                    const int trow = wr * 128 + mb * 32 + row;
                    size_t o;
                    const float* rin; float* rout;
                    if (tt == 0) { o = ((size_t)b * CTX + trow) * D; rin = ea.ctx_in; rout = ea.ctx_out; }
                    else { o = ((size_t)b * SEQ + (size_t)(tt - 1) * 256 + trow) * D; rin = ea.lat_in; rout = ea.lat_out; }
                    o += n0 + wc * 64 + half * 32;
#pragma unroll
                    for (int j = 0; j < 8; ++j) {
                        const f32x4 q = *(const f32x4*)(st + row * 68 + half * 32 + j * 4);
                        const f32x4 gv = *(const f32x4*)(gate + j * 4);
                        const f32x4 xi = *(const f32x4*)(rin + o + j * 4);
                        f32x4 y; y[0] = xi[0] + gv[0] * q[0]; y[1] = xi[1] + gv[1] * q[1]; y[2] = xi[2] + gv[2] * q[2]; y[3] = xi[3] + gv[3] * q[3];
                        *(f32x4*)(rout + o + j * 4) = y;
                    }
                } else {
                    const int row = lane >> 1, half = lane & 1;
                    float v[32];
#pragma unroll
                    for (int j = 0; j < 8; ++j) { const f32x4 q = *(const f32x4*)(st + row * 68 + half * 32 + j * 4); v[4 * j] = q[0]; v[4 * j + 1] = q[1]; v[4 * j + 2] = q[2]; v[4 * j + 3] = q[3]; }
#pragma unroll
                    for (int i = 0; i < 32; ++i) { const float x = fmaxf(v[i], 0.f); v[i] = x * x; }
                    bf16_t* dst = ea.out + (size_t)(Rbase + row) * ea.ldo + n0 + wc * 64 + half * 32;
#pragma unroll
                    for (int j = 0; j < 4; ++j)
                        *(bf16x8*)(dst + j * 8) = pack8(v[8 * j], v[8 * j + 1], v[8 * j + 2], v[8 * j + 3], v[8 * j + 4], v[8 * j + 5], v[8 * j + 6], v[8 * j + 7]);
                }
            }
            __syncthreads();
        }
    }
}

namespace g8 {
constexpr int BM = 256, BK = 64, HALF = 128, HT = HALF * BK, SPITCH = 260;
DI int lds_byte(int r, int c) { const int st = (r >> 4) * 2 + (c >> 5), rr = r & 15, cc = c & 31, ob = rr * 64 + cc * 2; return st * 1024 + (ob ^ (((ob >> 9) & 1) << 5)); }
DI void stage_rc(int b, int& R, int& C) { const int st = b / 1024, sb = b % 1024, swz = sb ^ (((sb >> 9) & 1) << 5); R = (st >> 1) * 16 + swz / 64; C = (st & 1) * 32 + (swz % 64) / 2; }
}

DI void inproj_pass(const EpiArgs& ea, LAS float* st, int cgl, int cgi, int rw  , int lane, int Rtile  ) {
    int kind; const float* g = nullptr; float scale = 1.f; int vt_grp = -1;
    if (cgi < 4) { kind = 0; g = ea.aq; scale = 0.125f * LOG2E; }
    else if (cgi < 6) { kind = 0; g = ea.ak; }
    else if (cgi < 8) { kind = 5; vt_grp = cgi - 6; }
    else if (cgi < 12) { kind = 1; g = ea.bq; scale = 0.17677669529663687f * LOG2E; }
    else if (cgi < 16) { kind = 1; g = ea.bk; }
    else if (cgi < 20) { kind = 5; vt_grp = 2 + cgi - 16; }
    else if (cgi < 24) { kind = 3; }
    else if (cgi < 28) { kind = 3; scale = 0.125f; vt_grp = 14 + cgi - 24; }
    else if (cgi < 32) { kind = 5; vt_grp = 6 + cgi - 28; }
    else if (cgi < 36) { kind = 4; }
    else if (cgi < 40) { kind = 2; g = ea.dq; scale = 0.125f * LOG2E; }
    else if (cgi < 44) { kind = 2; g = ea.dk; }
    else { kind = 5; vt_grp = 10 + cgi - 44; }
    if (vt_grp >= 0) {
        const int R0 = Rtile + rw * 64, b = R0 / T, t0 = R0 - b * T;
        bf16_t* dst = ea.vt + ((size_t)(b * NGRP + vt_grp) * 64 + lane) * T + t0;
#pragma unroll 1
        for (int hf = 0; hf < 2; ++hf) {
            float v[32];
#pragma unroll
            for (int rr = 0; rr < 32; ++rr) v[rr] = st[(rw * 64 + hf * 32 + rr) * g8::SPITCH + cgl * 64 + lane] * scale;
            if (vt_grp >= 2 && vt_grp < 6) {
                bf16_t* fd = ea.vt + (size_t)(b * NGRP + vt_grp) * 64 * T + (size_t)((t0 >> 5) + hf) * 2048 + (lane >> 5) * 1024 + (lane & 31) * 8;
#pragma unroll
                for (int j = 0; j < 4; ++j)
                    *(bf16x8*)(fd + (j >> 1) * 512 + (j & 1) * 256) = pack8(v[8 * j], v[8 * j + 1], v[8 * j + 2], v[8 * j + 3], v[8 * j + 4], v[8 * j + 5], v[8 * j + 6], v[8 * j + 7]);
            } else if (true) {
                bf16_t* fd = ea.vt + (size_t)(b * NGRP + vt_grp) * 64 * T + (size_t)((t0 >> 3) + hf * 4) * 512 + (lane >> 5) * 256 + (lane & 31) * 8;
#pragma unroll
                for (int j = 0; j < 4; ++j) {
                    const bf16x8 w8 = pack8(v[8 * j], v[8 * j + 1], v[8 * j + 2], v[8 * j + 3], v[8 * j + 4], v[8 * j + 5], v[8 * j + 6], v[8 * j + 7]);
                    if ((vt_grp >= 6 && vt_grp < 10) || vt_grp >= 14) stwt16(fd + j * 512, w8); else *(bf16x8*)(fd + j * 512) = w8;
                }
            } else {
#pragma unroll
                for (int j = 0; j < 4; ++j)
                    *(bf16x8*)(dst + hf * 32 + j * 8) = pack8(v[8 * j], v[8 * j + 1], v[8 * j + 2], v[8 * j + 3], v[8 * j + 4], v[8 * j + 5], v[8 * j + 6], v[8 * j + 7]);
            }
        }
    }
    if (vt_grp >= 0 && kind != 5) { asm volatile("s_waitcnt lgkmcnt(0)" ::: "memory"); __builtin_amdgcn_wave_barrier(); }
    if (kind != 5) {
        const int row = rw * 64 + lane, R = Rtile + row, b = R / T, t = R - b * T;
        const bool lat = t >= CTX; const int pos = t - CTX, pr = pos >> 6, pc = pos & 63;
        LAS float* srow = st + row * g8::SPITCH + cgl * 64;
        float ss64 = 0.f;
        if (kind == 0 || kind == 2) {
#pragma unroll
            for (int j = 0; j < 16; ++j) { const f32x4 q = *(const LAS f32x4*)(srow + j * 4); ss64 += q[0] * q[0] + q[1] * q[1] + q[2] * q[2] + q[3] * q[3]; }
        }
        const float rstd64 = rsqrtf(ss64 * (1.f / 64.f) + EPS);
        bf16_t* dst = ea.out + (size_t)R * NIN + cgi * 64;
#pragma unroll 1
        for (int hf = 0; hf < 2; ++hf) {
            float v[32];
#pragma unroll
            for (int j = 0; j < 8; ++j) { const f32x4 q = *(const LAS f32x4*)(srow + hf * 32 + j * 4); v[4 * j] = q[0]; v[4 * j + 1] = q[1]; v[4 * j + 2] = q[2]; v[4 * j + 3] = q[3]; }
            if (kind == 0 || kind == 2) {
#pragma unroll
                for (int i = 0; i < 32; ++i) v[i] *= rstd64 * g[hf * 32 + i];
                if (kind == 0 && lat) {
                    const int pp = hf ? pc : pr;
                    const float* tc = ea.tab + pp * 16; const float* ts = ea.tab + 1024 + pp * 16;
#pragma unroll
                    for (int i = 0; i < 16; ++i) { const float c = tc[i], sn = ts[i], x1 = v[i], x2 = v[i + 16]; v[i] = x1 * c - x2 * sn; v[i + 16] = x1 * sn + x2 * c; }
                }
            } else if (kind == 1) {
                float ss = 0.f;
#pragma unroll
                for (int i = 0; i < 32; ++i) ss += v[i] * v[i];
                const float rstd = rsqrtf(ss * (1.f / 32.f) + EPS);
#pragma unroll
                for (int i = 0; i < 32; ++i) v[i] *= rstd * g[i];
                if (lat) {
                    const float* tcr = ea.tab + 2048 + pr * 8; const float* tsr = ea.tab + 2560 + pr * 8;
                    const float* tcc = ea.tab + 2048 + pc * 8; const float* tsc = ea.tab + 2560 + pc * 8;
#pragma unroll
                    for (int i = 0; i < 8; ++i) {
                        { const float c = tcr[i], sn = tsr[i], x1 = v[i], x2 = v[i + 8]; v[i] = x1 * c - x2 * sn; v[i + 8] = x1 * sn + x2 * c; }
                        { const float c = tcc[i], sn = tsc[i], x1 = v[16 + i], x2 = v[24 + i]; v[16 + i] = x1 * c - x2 * sn; v[24 + i] = x1 * sn + x2 * c; }
                    }
                }
            } else if (kind == 4) {
#pragma unroll
                for (int i = 0; i < 32; ++i) v[i] = v[i] / (1.f + __expf(-v[i]));
            }
            if (cgi >= 12 && cgi < 16) {
                const int tile = t >> 5, kk = t & 31, rinv = ((kk >> 4) & 1) * 16 + ((kk >> 2) & 1) * 8 + ((kk >> 3) & 1) * 4 + (kk & 3);
                bf16_t* fd = ea.kfb + ((size_t)((b * 4 + (cgi - 12)) * 136 + tile)) * 2048 + hf * 1024 + rinv * 8;
#pragma unroll
                for (int j = 0; j < 4; ++j)
                    *(bf16x8*)(fd + (j >> 1) * 512 + (j & 1) * 256) = pack8(v[8 * j] * scale, v[8 * j + 1] * scale, v[8 * j + 2] * scale, v[8 * j + 3] * scale, v[8 * j + 4] * scale, v[8 * j + 5] * scale, v[8 * j + 6] * scale, v[8 * j + 7] * scale);
            } else if ((cgi >= 4 && cgi < 6) || (cgi >= 40 && cgi < 44)) {
                const int kh = (cgi < 6) ? (cgi - 4) : (2 + cgi - 40);
                bf16_t* fd = ea.kg8 + (size_t)(b * 6 + kh) * 64 * T + (size_t)(t >> 3) * 512 + hf * 256 + (t & 7) * 8;
#pragma unroll
                for (int j = 0; j < 4; ++j)
                    *(bf16x8*)(fd + (j >> 1) * 128 + (j & 1) * 64) = pack8(v[8 * j] * scale, v[8 * j + 1] * scale, v[8 * j + 2] * scale, v[8 * j + 3] * scale, v[8 * j + 4] * scale, v[8 * j + 5] * scale, v[8 * j + 6] * scale, v[8 * j + 7] * scale);
            } else {
                LAS bf16x8* seg = (LAS bf16x8*)srow;
#pragma unroll
                for (int j = 0; j < 4; ++j)
                    seg[hf * 4 + j] = pack8(v[8 * j] * scale, v[8 * j + 1] * scale, v[8 * j + 2] * scale, v[8 * j + 3] * scale, v[8 * j + 4] * scale, v[8 * j + 5] * scale, v[8 * j + 6] * scale, v[8 * j + 7] * scale);
            }
        }
        const bool tokmajor = !((cgi >= 12 && cgi < 16) || (cgi >= 4 && cgi < 6) || (cgi >= 40 && cgi < 44));
        if (tokmajor) {
            asm volatile("s_waitcnt lgkmcnt(0)" ::: "memory");
            __builtin_amdgcn_wave_barrier();
#pragma unroll
            for (int itr = 0; itr < 8; ++itr) {
                const int row_l = itr * 8 + (lane >> 3), chunk = lane & 7;
                const bf16x8 w = *(const LAS bf16x8*)((const LAS unsigned char*)(st + (rw * 64 + row_l) * g8::SPITCH + cgl * 64) + chunk * 16);
                *(bf16x8*)(ea.out + (size_t)(Rtile + rw * 64 + row_l) * NIN + cgi * 64 + chunk * 8) = w;
            }
        }
    }
}

template <int EPI>
__device__ void gemm_phase8(const bf16_t* __restrict__ A, const bf16_t* __restrict__ Bt, const int K, const int N, const EpiArgs& ea, unsigned char* lds, const bool skip_ctx, const int nsplit = 0, float* slab = nullptr, float* slab2 = nullptr) {
    using namespace g8;
    LAS unsigned char* ldsl = (LAS unsigned char*)lds;
    const int tidx = otid();
    const int wid = __builtin_amdgcn_readfirstlane(tidx >> 6), lane = tidx & 63, wr = wid >> 2, wc = wid & 3, fr = lane & 15, fq = lane >> 4;
    int sr0, sc0; stage_rc(tidx * 16, sr0, sc0);
    const unsigned gb0 = (unsigned)(sr0 * K + sc0) * 2u, gb1 = gb0 + 128u * (unsigned)K;
    const int aoff = lds_byte(wr * 64 + fr, fq * 8), boff = lds_byte(wc * 32 + fr, fq * 8);
    const unsigned ldsw = (unsigned)tidx * 16u;
#define SA(b, h) (((b) * 2 + (h)) * 16384)
#define SB(b, h) ((4 + (b) * 2 + (h)) * 16384)
#define STAGE(P, BASE, br, kt) do { const char* _sb = (const char*)(BASE + ((long)(br) * K + kbeg + (long)(kt) * BK)); \
    unsigned _g0 = gb0, _g1 = gb1; asm volatile("" : "+v"(_g0), "+v"(_g1)); \
    __builtin_amdgcn_global_load_lds((const unsigned*)(_sb + _g0), (LAS unsigned*)(ldsl + (P) + ldsw), 16, 0, 0); \
    __builtin_amdgcn_global_load_lds((const unsigned*)(_sb + _g1), (LAS unsigned*)(ldsl + (P) + ldsw + 8192), 16, 0, 0); } while (0)
#define LDA(dst, b, h) _Pragma("unroll") for (int m = 0; m < 4; ++m) _Pragma("unroll") for (int k = 0; k < 2; ++k) \
    dst[m][k] = *(const LAS bf16x8*)(ldsl + SA(b, h) + aoff + m * 2048 + k * 1024)
#define LDB(dst, b, h) _Pragma("unroll") for (int n = 0; n < 2; ++n) _Pragma("unroll") for (int k = 0; k < 2; ++k) \
    dst[n][k] = *(const LAS bf16x8*)(ldsl + SB(b, h) + boff + n * 2048 + k * 1024)
#define MMA(ai, bj, At, Bx) do { __builtin_amdgcn_s_setprio(1); \
    _Pragma("unroll") for (int m = 0; m < 4; ++m) _Pragma("unroll") for (int n = 0; n < 2; ++n) _Pragma("unroll") for (int k = 0; k < 2; ++k) \
      acc[ai][bj][m][n] = __builtin_amdgcn_mfma_f32_16x16x32_bf16(At[m][k], Bx[n][k], acc[ai][bj][m][n], 0, 0, 0); \
    __builtin_amdgcn_s_setprio(0); } while (0)
#define WAIT_V(n) asm volatile("s_waitcnt vmcnt(" #n ")" ::: "memory")
#define WAIT_L(n) asm volatile("s_waitcnt lgkmcnt(" #n ")" ::: "memory")
#define BAR __builtin_amdgcn_s_barrier()
#define SCHED __builtin_amdgcn_sched_barrier(0)
    const int nMe = skip_ctx ? 64 : 68, nN = N / BM, ntiles = nMe * nN, nextra = nsplit * 4 * nN;
    for (int tile = blockIdx.x; tile < ntiles + nextra; tile += gridDim.x) {
        int pme, pn, kbeg = 0, nt = K / BK, pslot = -1;
        if (tile >= ntiles) {
            const int e = tile - ntiles, ct = e / nsplit, sidx = e - ct * nsplit;
            pme = (ct / nN) * 17; pn = ct % nN; nt = K / BK / nsplit; kbeg = sidx * nt * BK; pslot = e;
        } else {
            int wgid = tile; const int q = ntiles / 8, rr = ntiles % 8, xcd = wgid % 8, off = wgid / 8;
            wgid = (xcd < rr ? xcd * (q + 1) : rr * (q + 1) + (xcd - rr) * q) + off;
            const int nig = 8 * nN, gid = wgid / nig, fm = gid * 8, gsz = (nMe - fm) < 8 ? (nMe - fm) : 8;
            pme = fm + ((wgid % nig) % gsz); pn = (wgid % nig) / gsz;
        }
        const int pm = (skip_ctx && pslot < 0) ? (pme + pme / 16 + 1) : pme;
        const int brow = pm * BM, bcol = pn * BM;
        f32x4 acc[2][2][4][2];
#pragma unroll
        for (int a = 0; a < 2; ++a)
#pragma unroll
            for (int b = 0; b < 2; ++b)
#pragma unroll
                for (int m = 0; m < 4; ++m)
#pragma unroll
                    for (int n = 0; n < 2; ++n) acc[a][b][m][n] = (f32x4){0.f, 0.f, 0.f, 0.f};
        bf16x8 At[4][2], B0[2][2], B1[2][2];
        STAGE(SB(0, 0), Bt, bcol, 0); STAGE(SA(0, 0), A, brow, 0);
        STAGE(SB(0, 1), Bt, bcol + HALF, 0); STAGE(SA(0, 1), A, brow + HALF, 0);
        if (wr == 1) BAR;
        WAIT_V(4); BAR;
        STAGE(SB(1, 0), Bt, bcol, 1); STAGE(SA(1, 0), A, brow, 1); STAGE(SB(1, 1), Bt, bcol + HALF, 1);
        WAIT_V(6); BAR;
        for (int t = 0; t < nt - 2; t += 2) {
            LDB(B0, 0, 0); SCHED; LDA(At, 0, 0); STAGE(SA(1, 1), A, brow + HALF, t + 1);
            WAIT_L(8); BAR; WAIT_L(0); MMA(0, 0, At, B0); BAR; SCHED;
            LDB(B1, 0, 1); STAGE(SB(0, 0), Bt, bcol, t + 2);
            BAR; WAIT_L(0); MMA(0, 1, At, B1); BAR;
            LDA(At, 0, 1); STAGE(SA(0, 0), A, brow, t + 2);
            BAR; WAIT_L(0); MMA(1, 0, At, B0); BAR; SCHED;
            STAGE(SB(0, 1), Bt, bcol + HALF, t + 2);
            WAIT_V(6); BAR; MMA(1, 1, At, B1); BAR;
            LDB(B0, 1, 0); SCHED; LDA(At, 1, 0); STAGE(SA(0, 1), A, brow + HALF, t + 2);
            WAIT_L(8); BAR; WAIT_L(0); MMA(0, 0, At, B0); BAR; SCHED;
            LDB(B1, 1, 1); STAGE(SB(1, 0), Bt, bcol, t + 3);
            BAR; WAIT_L(0); MMA(0, 1, At, B1); BAR;
            LDA(At, 1, 1); STAGE(SA(1, 0), A, brow, t + 3);
            BAR; WAIT_L(0); MMA(1, 0, At, B0); BAR; SCHED;
            STAGE(SB(1, 1), Bt, bcol + HALF, t + 3);
            WAIT_V(6); BAR; MMA(1, 1, At, B1); BAR;
        }
        { LDB(B0, 0, 0); LDA(At, 0, 0); STAGE(SA(1, 1), A, brow + HALF, nt - 1);
          BAR; WAIT_L(0); MMA(0, 0, At, B0); BAR;
          LDB(B1, 0, 1); BAR; WAIT_L(0); MMA(0, 1, At, B1); BAR;
          LDA(At, 0, 1); WAIT_V(4); BAR; WAIT_L(0); MMA(1, 0, At, B0); MMA(1, 1, At, B1); BAR; }
        { LDB(B0, 1, 0); LDA(At, 1, 0); WAIT_V(2); BAR; WAIT_L(0); MMA(0, 0, At, B0); BAR;
          LDB(B1, 1, 1); WAIT_V(0); BAR; WAIT_L(0); MMA(0, 1, At, B1); BAR;
          LDA(At, 1, 1); BAR; WAIT_L(0); MMA(1, 0, At, B0); MMA(1, 1, At, B1); BAR; }
        if (wr == 0) BAR;
        __syncthreads();
        LAS float* st = (LAS float*)ldsl;
        const int etid = otid(), elane = etid & 63, ewid = __builtin_amdgcn_readfirstlane(etid >> 6);
#pragma unroll
        for (int ai = 0; ai < 2; ++ai) {
            if (ai) __syncthreads();
#pragma unroll
            for (int bj = 0; bj < 2; ++bj)
#pragma unroll
                for (int m = 0; m < 4; ++m)
#pragma unroll
                    for (int n = 0; n < 2; ++n)
#pragma unroll
                        for (int j = 0; j < 4; ++j) st[(wr * 64 + m * 16 + fq * 4 + j) * SPITCH + bj * 128 + wc * 32 + n * 16 + fr] = acc[ai][bj][m][n][j];
            __syncthreads();
            const int Rtile = brow + ai * 128;
            if (EPI == EPI_INPROJ) {
                inproj_pass(ea, st, ewid & 3, (bcol >> 6) + (ewid & 3), ewid >> 2, elane, Rtile);
            } else {
                const int b = pm / 17, tt = pm % 17;
                const float* gate = ea.gate + ((tt == 0) ? 4 : b) * 6144 + bcol;
                const float* rin; float* rout; size_t o0;
                if (tt == 0) { o0 = ((size_t)b * CTX + ai * 128) * D; rin = ea.ctx_in; rout = ea.ctx_out; }
                else { o0 = ((size_t)b * SEQ + (size_t)(tt - 1) * 256 + ai * 128) * D; rin = ea.lat_in; rout = ea.lat_out; }
#pragma unroll 4
                for (int i = 0; i < 16; ++i) {
                    const int f = etid + i * 512, row = f >> 6, c4 = f & 63;
                    const f32x4 q = *(const LAS f32x4*)(st + row * SPITCH + c4 * 4);
                    if (EPI == EPI_RESID && pslot >= 0) {
                        const int ct = pslot / nsplit, sidx = pslot - ct * nsplit;
                        *(f32x4*)((sidx < 4 ? slab : slab2) + ((size_t)(((sidx & 3) * 16 + ct) * 256 + ai * 128 + row)) * 256 + c4 * 4) = q;
                    } else if (EPI == EPI_RESID) {
                        const size_t o = o0 + (size_t)row * D + bcol + c4 * 4;
                        const f32x4 gv = *(const f32x4*)(gate + c4 * 4);
                        const f32x4 xi = *(const f32x4*)(rin + o);
                        f32x4 y; y[0] = xi[0] + gv[0] * q[0]; y[1] = xi[1] + gv[1] * q[1]; y[2] = xi[2] + gv[2] * q[2]; y[3] = xi[3] + gv[3] * q[3];
                        *(f32x4*)(rout + o) = y;
                    } else {
                        const float x0 = fmaxf(q[0], 0.f), x1 = fmaxf(q[1], 0.f), x2 = fmaxf(q[2], 0.f), x3 = fmaxf(q[3], 0.f);
                        u32x2 w = {pk2(x0 * x0, x1 * x1), pk2(x2 * x2, x3 * x3)};
                        *(u32x2*)(ea.out + (size_t)(Rtile + row) * ea.ldo + bcol + c4 * 4) = w;
                    }
                }
            }
        }
        if (EPI == EPI_INPROJ && ea.kvcnt != nullptr && (pn == 6 || pn == 7)) {
            asm volatile("s_waitcnt vmcnt(0)" ::: "memory");
            __syncthreads();
            if (etid == 0) __hip_atomic_fetch_add(ea.kvcnt, 1u, __ATOMIC_RELAXED, __HIP_MEMORY_SCOPE_AGENT);
        }
        __syncthreads();
    }
#undef SA
#undef SB
#undef STAGE
#undef LDA
#undef LDB
#undef MMA
#undef WAIT_V
#undef WAIT_L
#undef BAR
#undef SCHED
}

struct A64 { f32x16 o0, o1; float l; };
template <int KSD = 16>
DI void qk64(const bf16_t* kp, const bf16x8 (&qf)[4], f32x16& s) {
    s = zero16();
#pragma unroll
    for (int ks = 0; ks < 4; ++ks) s = mfma(ldg8(kp + ks * KSD), qf[ks], s);
}
template <int SL = 16, int DBO = 32 * T>
DI void pv64(const bf16_t* vp, bf16x8 p0, bf16x8 p1, f32x16& o0, f32x16& o1) {
    o0 = mfma(ldg8(vp), p0, o0);
    o0 = mfma(ldg8(vp + SL), p1, o0);
    o1 = mfma(ldg8(vp + DBO), p0, o1);
    o1 = mfma(ldg8(vp + DBO + SL), p1, o1);
}
DI int k8off(int tk, int r, int h) { const int key = keyperm(r); return ((tk >> 3) + (key >> 3)) * 512 + h * 64 + (key & 7) * 8; }
DI int v8off(int tk, int r, int h) { return ((tk >> 3) + h) * 512 + r * 8; }
DI void pack_p(const f32x16& s, bf16x8& p0, bf16x8& p1) {
    p0 = pack8(s[0], s[1], s[2], s[3], s[4], s[5], s[6], s[7]);
    p1 = pack8(s[8], s[9], s[10], s[11], s[12], s[13], s[14], s[15]);
}
DI void tile_plain(const bf16_t* kp, const bf16_t* vp, const bf16x8 (&qf)[4], float shift, A64& a) {
    f32x16 s; qk64<128>(kp, qf, s);
#pragma unroll
    for (int i = 0; i < 16; ++i) { const float p = ex2(s[i] - shift); a.l += p; s[i] = p; }
    bf16x8 p0, p1; pack_p(s, p0, p1); pv64<1024, 256>(vp, p0, p1, a.o0, a.o1);
}
DI void store_o64(bf16_t* dst, const f32x16& o0, const f32x16& o1, float mul) {
#pragma unroll
    for (int q4 = 0; q4 < 4; ++q4) {
        u32x2 a = {pk2(o0[4 * q4] * mul, o0[4 * q4 + 1] * mul), pk2(o0[4 * q4 + 2] * mul, o0[4 * q4 + 3] * mul)};
        u32x2 b = {pk2(o1[4 * q4] * mul, o1[4 * q4 + 1] * mul), pk2(o1[4 * q4 + 2] * mul, o1[4 * q4 + 3] * mul)};
        *(u32x2*)(dst + 8 * q4) = a; *(u32x2*)(dst + 32 + 8 * q4) = b;
    }
}

template <class TK, class SOFT>
DI void attn64_run(const bf16_t* kbase, const bf16_t* vbase, const bf16x8 (&qf)[4], int n, int r, int h, TK tk_of, SOFT soft, f32x16& o0, f32x16& o1, float& lsum) {
    bf16x8 ka[4], va[4], kb[4], vb[4];
#define A64_LOAD(KK, VV, i_) do { const int _t = tk_of(((i_) < n) ? (i_) : n - 1); const bf16_t* _kp = kbase + k8off(_t, r, h); const bf16_t* _vp = vbase + v8off(_t, r, h); \
        _Pragma("unroll") for (int ks = 0; ks < 4; ++ks) KK[ks] = ldg8(_kp + ks * 128); \
        VV[0] = ldg8(_vp); VV[1] = ldg8(_vp + 1024); VV[2] = ldg8(_vp + 256); VV[3] = ldg8(_vp + 1280); } while (0)
#define A64_STEP(KK, VV, KZ, VZ, i_) do { \
        A64_LOAD(KZ, VZ, (i_) + 1); \
        __builtin_amdgcn_sched_barrier(0); \
        f32x16 s_ = zero16(); \
        _Pragma("unroll") for (int ks = 0; ks < 4; ++ks) s_ = mfma(KK[ks], qf[ks], s_); \
        lsum += soft((i_), s_); \
        bf16x8 p0_, p1_; pack_p(s_, p0_, p1_); \
        o0 = mfma(VV[0], p0_, o0); o1 = mfma(VV[2], p0_, o1); o0 = mfma(VV[1], p1_, o0); o1 = mfma(VV[3], p1_, o1); \
        __builtin_amdgcn_sched_barrier(0); } while (0)
    A64_LOAD(ka, va, 0);
#pragma unroll 1
    for (int i = 0; i < n; i += 2) {
        A64_STEP(ka, va, kb, vb, i);
        if (i + 1 < n) A64_STEP(kb, vb, ka, va, i + 1);
    }
#undef A64_LOAD
#undef A64_STEP
}

struct MixArgs { const LAS float* rpb_l; const LAS float* gains_l;     const bf16_t* qkv; const bf16_t* vt; const bf16_t* kfb; const bf16_t* kg8; bf16_t* mix; const float* cst; const float* rpb; const float* subln; const float* gn; const bf16_t* sin; };

__device__ void attnA_item(const MixArgs& ma, int it, bool ctxq) {
    const int lane = otid() & 63, r = lane & 31, h = lane >> 5;
    int b, head, qb;
    if (!ctxq) { b = it >> 9; head = (it >> 7) & 3; qb = it & 127; } else { b = it >> 5; head = (it >> 3) & 3; qb = it & 7; }
    const int g = head >> 1;
    const int q0 = qb * 32;
    const int Rq = b * T + (ctxq ? 0 : CTX) + q0 + r;
    const float shift = ma.cst[2];
    bf16x8 qf[4];
#pragma unroll
    for (int ks = 0; ks < 4; ++ks) qf[ks] = ldg8(ma.qkv + (size_t)Rq * NIN + head * 64 + ks * 16 + h * 8);
    const bf16_t* kbase = ma.kg8 + (size_t)(b * 6 + g) * 64 * T;
    const bf16_t* vbase = ma.vt + (size_t)(b * NGRP + g) * 64 * T;
    A64 a; a.o0 = zero16(); a.o1 = zero16(); a.l = 0.f;
    {
        const int kt_lo = ctxq ? 0 : max(-4, -(q0 >> 5)), kt_hi = ctxq ? -1 : min(4, (SEQ - 32 - q0) >> 5), nwin = kt_hi - kt_lo + 1;
        auto tk_of = [&](int i) { return (i < nwin) ? (CTX + q0 + (kt_lo + i) * 32) : (i - nwin) * 32; };
        auto soft = [&](int i, f32x16& sc) {
            const int kt = (i < nwin) ? kt_lo + i : 0;
            float sum = 0.f;
#pragma unroll
            for (int e = 0; e < 16; ++e) {
                const int kk = kidx(e, h);
                const bool valid = (kt == -4) ? (kk >= r) : (kt == 4) ? (kk <= r) : true;
                const float pp = valid ? ex2(sc[e] - shift) : 0.f; sum += pp; sc[e] = pp;
            }
            return sum;
        };
        attn64_run(kbase, vbase, qf, nwin + 8, r, h, tk_of, soft, a.o0, a.o1, a.l);
    }
    float l = a.l + __shfl_xor(a.l, 32);
    l += ex2(ma.cst[16 + head] - shift);
    store_o64(ma.mix + (size_t)Rq * D + head * 64 + 4 * h, a.o0, a.o1, 1.f / l);
}

__device__ void attnD_item(const MixArgs& ma, int it, bool ctxq) {
    const int lane = otid() & 63, r = lane & 31, h = lane >> 5;
    const float shift = ma.cst[4];
    int b, head, Rq, rp = 0, j = 0, qr = 0, qc = 0;
    if (!ctxq) {
        b = it >> 9; head = (it >> 7) & 3; const int rem = it & 127; rp = rem >> 2; j = rem & 3;
        qr = 2 * rp + (r >> 4); qc = 16 * j + (r & 15);
        Rq = b * T + CTX + qr * 64 + qc;
    } else { b = it >> 5; head = (it >> 3) & 3; Rq = b * T + (it & 7) * 32 + r; }
    bf16x8 qf[4];
#pragma unroll
    for (int ks = 0; ks < 4; ++ks) qf[ks] = ldg8(ma.qkv + (size_t)Rq * NIN + 2304 + head * 64 + ks * 16 + h * 8);
    const bf16_t* kbase = ma.kg8 + (size_t)(b * 6 + 2 + head) * 64 * T;
    const bf16_t* vbase = ma.vt + (size_t)(b * NGRP + 10 + head) * 64 * T;
    A64 a; a.o0 = zero16(); a.o1 = zero16(); a.l = 0.f;
    {
        const int rs = min(max(qr - 4, 0), 56), cs = min(max(qc - 8, 0), 48);
        const int c0 = min(max(16 * j - 8, 0), 32);
        const int kr_lo = min(max(2 * rp - 4, 0), 56), kr_hi = min(max(2 * rp + 1 - 4, 0), 56) + 7;
        const int nwin = ctxq ? 0 : (kr_hi - kr_lo + 1);
        const LAS float* rpb = ma.rpb_l + head * 465;
        auto tk_of = [&](int i) { return (i < nwin) ? (CTX + (kr_lo + i) * 64 + c0) : (i - nwin) * 32; };
        auto soft = [&](int i, f32x16& sc) {
            float sum = 0.f;
            if (i < nwin) {
                const int kr = kr_lo + i;
                const bool rowok = (kr >= rs) && (kr < rs + 8);
#pragma unroll
                for (int e = 0; e < 16; ++e) {
                    const int kc = c0 + kidx(e, h);
                    const bool valid = rowok && (kc >= cs) && (kc < cs + 16);
                    float pp = 0.f;
                    if (valid) { const float bias = rpb[(kr - qr + 7) * 31 + (kc - qc + 15)]; pp = ex2(sc[e] + bias * LOG2E - shift); }
                    sum += pp; sc[e] = pp;
                }
            } else {
#pragma unroll
                for (int e = 0; e < 16; ++e) { const float pp = ex2(sc[e] - shift); sum += pp; sc[e] = pp; }
            }
            return sum;
        };
        attn64_run(kbase, vbase, qf, nwin + 8, r, h, tk_of, soft, a.o0, a.o1, a.l);
    }
    const float l = a.l + __shfl_xor(a.l, 32);
    store_o64(ma.mix + (size_t)Rq * D + 768 + head * 64 + 4 * h, a.o0, a.o1, 1.f / l);
}

template <bool SHIFT, bool COOP>
__device__ void attnB_item(const MixArgs& ma, int it, bool ctxq, LAS unsigned char* ring = nullptr) {
    const int tidb = otid(), lane = tidb & 63, r = lane & 31, h = lane >> 5;
    int b, head, qb;
    if (!ctxq) { b = it >> 9; head = (it >> 7) & 3; qb = it & 127; } else { b = it >> 5; head = (it >> 3) & 3; qb = it & 7; }
    const int Rq = b * T + (ctxq ? 0 : CTX) + qb * 32 + r;
    const float shift = ma.cst[3];
    bf16x8 q1[2], q2[2];
#pragma unroll
    for (int ks = 0; ks < 2; ++ks) {
        q1[ks] = ldg8(ma.qkv + (size_t)Rq * NIN + 512 + head * 64 + ks * 16 + h * 8);
        q2[ks] = ldg8(ma.qkv + (size_t)Rq * NIN + 512 + head * 64 + 32 + ks * 16 + h * 8);
    }
    const bf16_t* kp = ma.kfb + (size_t)((b * 4 + head) * 136) * 2048 + lane * 8;
    const bf16_t* vp = ma.vt + (size_t)(b * NGRP + 2 + head) * 64 * T + lane * 8;
    f32x16 o1a = zero16(), o1b = zero16(), o2a = zero16(), o2b = zero16();
    float l1 = 0.f, l2 = 0.f;
    const int ntile = ctxq ? 8 : (T / 32);
    const f32x16 sinit = zero16();
#define B_LOADK(KK, kt) do { const bf16_t* _k = kp + (kt) * 2048; KK[0] = ldg8(_k); KK[1] = ldg8(_k + 512); KK[2] = ldg8(_k + 1024); KK[3] = ldg8(_k + 1536); } while (0)
#define B_LOADV(VV, kt) do { const bf16_t* _v = vp + (kt) * 2048; VV[0] = ldg8(_v); VV[1] = ldg8(_v + 512); VV[2] = ldg8(_v + 1024); VV[3] = ldg8(_v + 1536); } while (0)
#define B_QK(KK, S1, S2) do { S1 = mfma(KK[0], q1[0], sinit); S1 = mfma(KK[1], q1[1], S1); S2 = mfma(KK[2], q2[0], sinit); S2 = mfma(KK[3], q2[1], S2); } while (0)
#define B_EXP8(S, o, P, L) do { \
        const float e0 = ex2(SHIFT ? S[o] - shift : S[o]), e1 = ex2(SHIFT ? S[o + 1] - shift : S[o + 1]), e2 = ex2(SHIFT ? S[o + 2] - shift : S[o + 2]), e3 = ex2(SHIFT ? S[o + 3] - shift : S[o + 3]); \
        const float e4 = ex2(SHIFT ? S[o + 4] - shift : S[o + 4]), e5 = ex2(SHIFT ? S[o + 5] - shift : S[o + 5]), e6 = ex2(SHIFT ? S[o + 6] - shift : S[o + 6]), e7 = ex2(SHIFT ? S[o + 7] - shift : S[o + 7]); \
        L += ((e0 + e1) + (e2 + e3)) + ((e4 + e5) + (e6 + e7)); P = pack8(e0, e1, e2, e3, e4, e5, e6, e7); } while (0)
#define B_SOFTPV(S1, S2, VV) do { \
        bf16x8 pa0, pa1, pb0, pb1; \
        B_EXP8(S1, 0, pa0, l1); B_EXP8(S1, 8, pa1, l1); B_EXP8(S2, 0, pb0, l2); B_EXP8(S2, 8, pb1, l2); \
        __builtin_amdgcn_sched_barrier(0); \
        o1a = mfma(VV[0], pa0, o1a); o1a = mfma(VV[1], pa1, o1a); o1b = mfma(VV[2], pa0, o1b); o1b = mfma(VV[3], pa1, o1b); \
        o2a = mfma(VV[0], pb0, o2a); o2a = mfma(VV[1], pb1, o2a); o2b = mfma(VV[2], pb0, o2b); o2b = mfma(VV[3], pb1, o2b); \
        } while (0)
    bf16x8 ones;
#pragma unroll
    for (int i = 0; i < 8; ++i) ones[i] = (short)0x3F80;
    f32x16 la = zero16(), lb = zero16();
    bf16x8 kf[4], vf[4];
    f32x16 s1, s2;
    if (COOP) {
        const bf16_t* gsrc = (tidb < 256) ? (ma.kfb + (size_t)((b * 4 + head) * 136) * 2048 + tidb * 8) : (ma.vt + (size_t)(b * NGRP + 2 + head) * 64 * T + (tidb - 256) * 8);
        LAS unsigned char* wdst = ring + tidb * 16;
        const LAS unsigned char* rsrc = ring + lane * 16;
        u32x4 rg = *(const u32x4*)gsrc;
        *(LAS u32x4*)wdst = rg;
        rg = *(const u32x4*)(gsrc + 2048);
        *(LAS u32x4*)(wdst + 8192) = rg;
        int st = 0, st2 = 2;
#pragma unroll 1
        for (int kt = 0; kt < ntile; ++kt) {
            if (kt + 2 < ntile) rg = *(const u32x4*)(gsrc + (size_t)(kt + 2) * 2048);
            __syncthreads();
            const LAS unsigned char* sp = rsrc + st * 8192;
#pragma unroll
            for (int f = 0; f < 4; ++f) { kf[f] = *(const LAS bf16x8*)(sp + f * 1024); vf[f] = *(const LAS bf16x8*)(sp + 4096 + f * 1024); }
            B_QK(kf, s1, s2);
            __builtin_amdgcn_sched_barrier(0);
            B_SOFTPV(s1, s2, vf);
            if (kt + 2 < ntile) *(LAS u32x4*)(wdst + st2 * 8192) = rg;
            st = (st == 2) ? 0 : st + 1; st2 = (st2 == 2) ? 0 : st2 + 1;
        }
        __syncthreads();
    } else {
    B_LOADK(kf, 0); B_LOADV(vf, 0);
#pragma unroll 1
    for (int kt = 0; kt < ntile; ++kt) {
        const int k1 = (kt + 1 < ntile) ? kt + 1 : ntile - 1;
        B_QK(kf, s1, s2);
        B_LOADK(kf, k1);
        __builtin_amdgcn_sched_barrier(0);
        B_SOFTPV(s1, s2, vf);
        B_LOADV(vf, k1);
        __builtin_amdgcn_sched_barrier(0);
    }
    }
    l1 += __shfl_xor(l1, 32); l2 += __shfl_xor(l2, 32);
#undef B_LOADK
#undef B_LOADV
#undef B_QK
#undef B_SOFTPV
#undef B_EXP8
    const float i1 = 1.f / l1, i2 = ma.cst[0] / l2;
    float ss = 0.f;
#pragma unroll
    for (int i = 0; i < 16; ++i) { o1a[i] = o1a[i] * i1 - o2a[i] * i2; o1b[i] = o1b[i] * i1 - o2b[i] * i2; ss += o1a[i] * o1a[i] + o1b[i] * o1b[i]; }
    ss += __shfl_xor(ss, 32);
    const float mul = rsqrtf(ss * (1.f / 64.f) + EPS) * ma.cst[1];
#pragma unroll
    for (int i = 0; i < 16; ++i) { const int d = crow(i, h); o1a[i] *= ma.gains_l[d]; o1b[i] *= ma.gains_l[32 + d]; }
    store_o64(ma.mix + (size_t)Rq * D + 256 + head * 64 + 4 * h, o1a, o1b, mul);
}

__device__ void retKV_item(const MixArgs& ma, int it, float* kvout) {
    const int lane = otid() & 63, r = lane & 31, h = lane >> 5;
    const int dir = it & 1, c = (it >> 1) % 34, bh = (it >> 1) / 34, b = bh >> 2, head = bh & 3;
    const float lg = dir ? ma.cst[12 + head] : ma.cst[8 + head];
    const bf16_t* vp = ma.vt + (size_t)(b * NGRP + 6 + head) * 64 * T + v8off(c * 128, r, h);
    const bf16_t* kp = ma.vt + (size_t)(b * NGRP + 14 + head) * 64 * T + v8off(c * 128, r, h);
    f32x16 acc[2][2];
    acc[0][0] = zero16(); acc[0][1] = zero16(); acc[1][0] = zero16(); acc[1][1] = zero16();
#pragma unroll
    for (int ks = 0; ks < 8; ++ks) {
        const bf16x8 v0 = ldg8(vp + ks * 1024), v1 = ldg8(vp + 256 + ks * 1024);
        bf16x8 k0 = ldg8(kp + ks * 1024), k1 = ldg8(kp + 256 + ks * 1024);
        float w[8];
#pragma unroll
        for (int j = 0; j < 8; ++j) { const int tl = ks * 16 + h * 8 + j; w[j] = ex2(lg * (float)(dir ? tl : (127 - tl))); }
        float f0[8], f1[8];
#pragma unroll
        for (int j = 0; j < 8; ++j) { f0[j] = bf2f((unsigned short)k0[j]) * w[j]; f1[j] = bf2f((unsigned short)k1[j]) * w[j]; }
        k0 = pack8(f0[0], f0[1], f0[2], f0[3], f0[4], f0[5], f0[6], f0[7]);
        k1 = pack8(f1[0], f1[1], f1[2], f1[3], f1[4], f1[5], f1[6], f1[7]);
        acc[0][0] = mfma(v0, k0, acc[0][0]); acc[0][1] = mfma(v0, k1, acc[0][1]);
        acc[1][0] = mfma(v1, k0, acc[1][0]); acc[1][1] = mfma(v1, k1, acc[1][1]);
    }
    float* dst = kvout + ((size_t)((bh * 2 + dir) * 34 + c)) * 4096;
#pragma unroll
    for (int db = 0; db < 2; ++db)
#pragma unroll
        for (int nb = 0; nb < 2; ++nb)
#pragma unroll
            for (int i = 0; i < 16; ++i) dst[(db * 32 + crow(i, h)) * 64 + nb * 32 + r] = acc[db][nb][i];
}

__device__ void ret_scan(const float* __restrict__ cst, const float* __restrict__ kv, bf16_t* __restrict__ sin) {
    const int n = NB * 4 * 2 * 4096;
    for (int e = blockIdx.x * 512 + otid(); e < n; e += gridDim.x * 512) {
        const int el = e & 4095, bhd = e >> 12, dir = bhd & 1, head = (bhd >> 1) & 3;
        const float lg = dir ? cst[12 + head] : cst[8 + head];
        const float dec = ex2(lg * 128.f);
        const size_t base = (size_t)bhd * 34 * 4096 + el;
        float v[34];
#pragma unroll
        for (int p = 0; p < 34; ++p) v[p] = kv[base + (size_t)p * 4096];
        float S = 0.f;
        if (dir == 0) {
#pragma unroll
            for (int p = 0; p < 34; ++p) { sin[base + (size_t)p * 4096] = (bf16_t)(pk2(S, 0.f) & 0xffffu); S = S * dec + v[p]; }
        } else {
            sin[base + 4096] = (bf16_t)(pk2(S, 0.f) & 0xffffu); S = S * dec + v[1];
            sin[base] = (bf16_t)(pk2(S, 0.f) & 0xffffu); S = S * dec + v[0];
#pragma unroll
            for (int c = 33; c >= 2; --c) { sin[base + (size_t)c * 4096] = (bf16_t)(pk2(S, 0.f) & 0xffffu); S = S * dec + v[c]; }
        }
    }
}

__device__ void retOut_item(const MixArgs& ma, int it) {
    const int lane = otid() & 63, r = lane & 31, h = lane >> 5;
    const int qs = it & 3, c = (it >> 2) % 34, bh = (it >> 2) / 34, b = bh >> 2, head = bh & 3;
    const float lgf = ma.cst[8 + head], lgb = ma.cst[12 + head];
    const int R0 = b * T + c * 128, Rq = R0 + qs * 32 + r, iq = qs * 32 + r;
    bf16x8 qf[4];
#pragma unroll
    for (int ks = 0; ks < 4; ++ks) qf[ks] = ldg8(ma.qkv + (size_t)Rq * NIN + 1280 + head * 64 + ks * 16 + h * 8);
    const bf16_t* kbase = ma.qkv + 1536 + head * 64 + h * 8;
    const bf16_t* vbase = ma.vt + (size_t)(b * NGRP + 6 + head) * 64 * T + v8off(c * 128, r, h);
    f32x16 o0 = zero16(), o1 = zero16();
    {
        bf16x8 kc[4], vc[4], kn[4], vn[4];
        const bf16_t* kp0 = kbase + (size_t)(R0 + keyperm(r)) * NIN;
#pragma unroll
        for (int ks = 0; ks < 4; ++ks) kc[ks] = ldg8(kp0 + ks * 16);
        vc[0] = ldg8(vbase); vc[1] = ldg8(vbase + 1024); vc[2] = ldg8(vbase + 256); vc[3] = ldg8(vbase + 1280);
#pragma unroll 1
        for (int kb = 0; kb < 4; ++kb) {
            {
                const int kn_i = (kb < 3) ? kb + 1 : kb;
                const bf16_t* kp = kp0 + (size_t)(kn_i * 32) * NIN; const bf16_t* vp = vbase + kn_i * 2048;
#pragma unroll
                for (int ks = 0; ks < 4; ++ks) kn[ks] = ldg8(kp + ks * 16);
                vn[0] = ldg8(vp); vn[1] = ldg8(vp + 1024); vn[2] = ldg8(vp + 256); vn[3] = ldg8(vp + 1280);
            }
            __builtin_amdgcn_sched_barrier(0);
            f32x16 s = zero16();
#pragma unroll
            for (int ks = 0; ks < 4; ++ks) s = mfma(kc[ks], qf[ks], s);
#pragma unroll
            for (int i = 0; i < 16; ++i) {
                const int jk = kb * 32 + kidx(i, h);
                const int dlt = iq - jk;
                const float w = (dlt > 0) ? ex2(lgf * (float)dlt) : (dlt < 0) ? ex2(lgb * (float)(-dlt)) : 2.f;
                s[i] *= w;
            }
            bf16x8 p0, p1; pack_p(s, p0, p1);
            o0 = mfma(vc[0], p0, o0); o1 = mfma(vc[2], p0, o1); o0 = mfma(vc[1], p1, o0); o1 = mfma(vc[3], p1, o1);
            __builtin_amdgcn_sched_barrier(0);
#pragma unroll
            for (int ks = 0; ks < 4; ++ks) { kc[ks] = kn[ks]; vc[ks] = vn[ks]; }
        }
    }
#pragma unroll
    for (int dir = 0; dir < 2; ++dir) {
        const bf16_t* sp = ma.sin + ((size_t)((bh * 2 + dir) * 34 + c)) * 4096 + r * 64 + h * 8;
        f32x16 x0 = zero16(), x1 = zero16();
#pragma unroll
        for (int ks = 0; ks < 4; ++ks) { x0 = mfma(ldg8(sp + ks * 16), qf[ks], x0); x1 = mfma(ldg8(sp + 32 * 64 + ks * 16), qf[ks], x1); }
        const float w = dir ? ex2(lgb * (float)(128 - iq)) : ex2(lgf * (float)(iq + 1));
#pragma unroll
        for (int i = 0; i < 16; ++i) { o0[i] += w * x0[i]; o1[i] += w * x1[i]; }
    }
    float ss = 0.f;
#pragma unroll
    for (int i = 0; i < 16; ++i) ss += o0[i] * o0[i] + o1[i] * o1[i];
    ss += __shfl_xor(ss, 32);
    const float mul = rsqrtf(ss * (1.f / 64.f) + EPS);
    const bf16_t* gp = ma.qkv + (size_t)Rq * NIN + 2048 + head * 64 + 4 * h;
#pragma unroll
    for (int q4 = 0; q4 < 4; ++q4) {
        const u32x2 ga = *(const u32x2*)(gp + 8 * q4), gb = *(const u32x2*)(gp + 32 + 8 * q4);
#pragma unroll
        for (int e = 0; e < 4; ++e) {
            const int i = 4 * q4 + e, d = crow(i, h);
            const float gta = bf2f((unsigned short)((e & 1) ? (ga[e >> 1] >> 16) : (ga[e >> 1] & 0xffffu)));
            const float gtb = bf2f((unsigned short)((e & 1) ? (gb[e >> 1] >> 16) : (gb[e >> 1] & 0xffffu)));
            o0[i] *= ma.gains_l[64 + d] * gta; o1[i] *= ma.gains_l[96 + d] * gtb;
        }
    }
    store_o64(ma.mix + (size_t)Rq * D + 512 + head * 64 + 4 * h, o0, o1, mul);
}

__global__ void __launch_bounds__(512) fwd_kernel(Params p) {
    extern __shared__ __attribute__((aligned(16))) unsigned char lds[];
    cg::grid_group grid = cg::this_grid();
    volatile LAS unsigned* xbw = (volatile LAS unsigned*)(lds + LDS_MAIN);
    if (threadIdx.x == 0) { xbw[0] = 0u; xbw[1] = 0u; xbw[2] = 0u; xbw[3] = 0u; }
    __syncthreads();
    XcdBarrier xb = xcd_barrier_post((unsigned*)(p.ws + WS_BAR), xbw);

    unsigned char* ws = p.ws;
    float* tab = (float*)(ws + WS_TAB);
    float* modb = (float*)(ws + WS_MOD);
    float* ctxb = (float*)(ws + WS_CTXB);
    bf16_t* act = (bf16_t*)(ws + WS_ACT);
    float* kvb = (float*)(ws + WS_KV);
    bf16_t* sinb = (bf16_t*)(ws + WS_SIN);
    bf16_t* qkv = (bf16_t*)(ws + WS_QKV);
    bf16_t* vt = (bf16_t*)(ws + WS_VT);
    bf16_t* ub = (bf16_t*)(ws + WS_QKV);
    const bf16_t* w_in = (const bf16_t*)(ws + WS_W + W_IN_OFF);
    const bf16_t* w_out = (const bf16_t*)(ws + WS_W + W_OUT_OFF);
    const bf16_t* w_1 = (const bf16_t*)(ws + WS_W + W_1_OFF);
    const bf16_t* w_2 = (const bf16_t*)(ws + WS_W + W_2_OFF);
    const int nw = gridDim.x * 8;
    float* slabb = (float*)(ws + WS_KV);
    constexpr int NSPLIT = 8;
    float* slabb2 = (float*)(ws + WS_QKV + 142606336);
#define GW (blockIdx.x * 8 + (otid() >> 6))

    { int nr0 = (PROBE_DUP == 6) ? 2 : 1; asm volatile("" : "+s"(nr0));
#pragma unroll 1
      for (int rep = 0; rep < nr0; ++rep) {
    if (blockIdx.x == 0) prep_tables(p);
    for (int it = blockIdx.x; it < 192; it += gridDim.x) mod_item(p, it, lds);
    conv_layer(p, 0, lds, 0, 768, 0, gridDim.x);
      } }
    if (p.ws == nullptr) grid.sync();
    if (threadIdx.x == 0) { unsigned nloc, nx; xcd_barrier_complete(xb.bar, xb.x, nloc, nx); xbw[0] = nloc; xbw[1] = nx; }
    __syncthreads();
    xcd_barrier(xb);

#pragma nounroll
    for (int l = 0; l < 2; ++l) {
        const float* modl = modb + l * 5 * 6144;
        const float* cst = tab + 3072 + l * 32;
        const float* lat_in = (l == 0) ? p.in[0] : p.out;
        const float* ctx_in = (l == 0) ? p.in[2] : ctxb;
        if (l == 1 && (1088 % gridDim.x) == 0) conv_layer(p, 1, lds, 0, 768, 0, gridDim.x);
        { int nr = (PROBE_DUP == 4) ? 2 : 1; asm volatile("" : "+s"(nr));
#pragma unroll 1
          for (int rep = 0; rep < nr; ++rep) norm_phase(lat_in, ctx_in, p.in[6] + l * D, modl, 0, 1024, act, false, slabb, (l == 1) ? NSPLIT : 0, modb + 4 * 6144 + 5120, nullptr, slabb2); }
        xcd_barrier(xb);
        if (PROBE_DUP == 7) xcd_barrier(xb);
        MixArgs ma{}; ma.qkv = qkv; ma.vt = vt; ma.kfb = (const bf16_t*)(ws + WS_KFB); ma.kg8 = (const bf16_t*)(ws + WS_KG8); ma.mix = act; ma.cst = cst; ma.rpb = p.in[25] + l * 1860; ma.subln = p.in[19] + l * 64; ma.gn = p.in[22] + l * 64; ma.sin = sinb;
        const int nb4 = 816 % gridDim.x;
        const bool kv_early = nb4 != 0;
        {
            EpiArgs ea{}; ea.out = qkv; ea.ldo = NIN; ea.vt = vt; ea.kfb = (bf16_t*)(ws + WS_KFB); ea.kg8 = (bf16_t*)(ws + WS_KG8); ea.tab = tab;
            ea.aq = p.in[10] + l * 64; ea.ak = p.in[11] + l * 64; ea.bq = p.in[13] + l * 32; ea.bk = p.in[14] + l * 32; ea.dq = p.in[23] + l * 64; ea.dk = p.in[24] + l * 64;
            unsigned* kvcnt = (unsigned*)(ws + WS_BAR) + 3520 + l * 64;
            ea.kvcnt = kv_early ? kvcnt : nullptr;
            { int nr8 = (PROBE_DUP == 8) ? 2 : 1; asm volatile("" : "+s"(nr8));
#pragma unroll 1
              for (int rep = 0; rep < nr8; ++rep) gemm_phase8<EPI_INPROJ>(act, w_in, 1024, NIN, ea, lds, false); }
            conv_layer(p, l, lds, 768, 3072, nb4, gridDim.x - nb4);
            if (kv_early && (int)blockIdx.x >= nb4) {
                if (threadIdx.x == 0) {
                    unsigned sp = 0;
                    while (__hip_atomic_load(kvcnt, __ATOMIC_RELAXED, __HIP_MEMORY_SCOPE_AGENT) < 136u) { __builtin_amdgcn_s_sleep(2); if (++sp > (1u << 22)) { atomicAdd((unsigned*)(ws + WS_BAR) + XB_TMO, 1u); break; } }
                    __builtin_amdgcn_fence(__ATOMIC_ACQUIRE, "agent");
                    asm volatile("s_waitcnt vmcnt(0)" ::: "memory");
                }
                __syncthreads();
                const int nidle = gridDim.x - nb4;
                for (int it = ((int)blockIdx.x - nb4) * 8 + (otid() >> 6); it < NB * 4 * 34 * 2; it += nidle * 8) retKV_item(ma, it, kvb);
            }
        }
        xcd_barrier(xb);
        if (!kv_early) {
            for (int it = GW; it < NB * 4 * 34 * 2; it += nw) retKV_item(ma, it, kvb);
            xcd_barrier(xb);
        }
        { int nr = (PROBE_DUP == 5) ? 2 : 1; asm volatile("" : "+s"(nr));
#pragma unroll 1
          for (int rep = 0; rep < nr; ++rep) ret_scan(cst, kvb, sinb); }
        xcd_barrier(xb);
        if (PROBE_DUP == 7) xcd_barrier(xb);
        {
            LAS float* rl = (LAS float*)(lds + 65536);
            for (int i = otid(); i < 1860; i += 512) rl[i] = ma.rpb[i];
            if (otid() < 128) rl[2048 + otid()] = (otid() < 64) ? ma.subln[otid()] : ma.gn[otid() - 64];
            ma.rpb_l = rl; ma.gains_l = rl + 2048;
            __syncthreads();
        }
        {
            const int wv = otid() >> 6;
            const bool noshift = cst[3] <= 64.f;
            for (int itb = blockIdx.x; itb < 256; itb += gridDim.x) {
                if (wv < 4) {
#pragma unroll 1
                    for (int k = 0; k < 2; ++k) {
                        const int it = itb * 8 + 2 * wv + k;
                        if (noshift) attnB_item<false, false>(ma, it, false); else attnB_item<true, false>(ma, it, false);
                    }
                } else {
                    __builtin_amdgcn_s_setprio(2);
#pragma unroll 1
                    for (int k = 0; k < 2; ++k) {
                        const int it = itb * 8 + 2 * (wv - 4) + k;
                        attnA_item(ma, it, false);
                        attnD_item(ma, it, false);
                        retOut_item(ma, ((it >> 7) * 34 + 2 + ((it & 127) >> 2)) * 4 + (it & 3));
                    }
                    __builtin_amdgcn_s_setprio(0);
                }
            }
            if (l == 0 && wv >= 4) {
                const int pw = blockIdx.x * 4 + (wv - 4), npw = gridDim.x * 4;
                for (int i = pw; i < 128; i += npw) retOut_item(ma, ((i >> 3) * 34 + ((i & 7) >> 2)) * 4 + (i & 3));
                for (int it = (pw + npw - 256 % npw) % npw; it < 128; it += npw) attnB_item<true, false>(ma, it, true);
                for (int it = (pw + npw - 512 % npw) % npw; it < 128; it += npw) attnA_item(ma, it, true);
                for (int it = (pw + npw - 768 % npw) % npw; it < 128; it += npw) attnD_item(ma, it, true);
            }
        }
        xcd_barrier(xb);
        if (PROBE_DUP == 7) xcd_barrier(xb);
        {
            EpiArgs ea{}; ea.lat_in = lat_in; ea.ctx_in = ctx_in; ea.lat_out = p.out; ea.ctx_out = ctxb; ea.gate = modl + 2048;
            gemm_phase8<EPI_RESID>(act, w_out, 1024, 1024, ea, lds, true, (l == 0) ? NSPLIT : 0, slabb, slabb2);
        }
        xcd_barrier(xb);
        if (PROBE_DUP == 7) xcd_barrier(xb);
        { int nr = (PROBE_DUP == 4) ? 2 : 1; asm volatile("" : "+s"(nr));
#pragma unroll 1
          for (int rep = 0; rep < nr; ++rep) norm_phase(p.out, (l == 0) ? ctx_in : ctxb, p.in[7] + l * D, modl, 3072, 4096, act, l == 1, slabb, (l == 0) ? NSPLIT : 0, modl + 4 * 6144 + 2048, ctxb, slabb2); }
        xcd_barrier(xb);
        if (PROBE_DUP == 7) xcd_barrier(xb);
        {
            EpiArgs ea{}; ea.out = ub; ea.ldo = DFF;
            int nrep = (PROBE_DUP == 1) ? 2 : 1; asm volatile("" : "+s"(nrep));
#pragma unroll 1
            for (int rep = 0; rep < nrep; ++rep) gemm_phase8<EPI_RELU2>(act, w_1, 1024, DFF, ea, lds, l == 1);
            if (l == 0 && (1088 % gridDim.x) != 0) { const int nb5 = 1088 % gridDim.x; conv_layer(p, 1, lds, 0, 768, nb5, gridDim.x - nb5); }
        }
        xcd_barrier(xb);
        if (PROBE_DUP == 7) xcd_barrier(xb);
        {
            EpiArgs ea{}; ea.lat_in = p.out; ea.ctx_in = ctxb; ea.lat_out = p.out; ea.ctx_out = ctxb; ea.gate = modl + 5120;
            gemm_phase8<EPI_RESID>(ub, w_2, 4096, 1024, ea, lds, true, (l == 0) ? NSPLIT : 0, slabb, slabb2);
        }
        if (l == 0) xcd_barrier(xb);
    }
}

extern "C" void kernel_launch(void* const* d_in, const int* in_sizes, int n_in, void* d_out, int out_size, void* d_ws, size_t ws_size, hipStream_t stream) {
    static int grid_blocks = 0;
    if (!grid_blocks) {
        int dev = 0, cus = 0, per_cu = 0;
        hipGetDevice(&dev);
        hipDeviceGetAttribute(&cus, hipDeviceAttributeMultiprocessorCount, dev);
        hipFuncSetAttribute((const void*)fwd_kernel, hipFuncAttributeMaxDynamicSharedMemorySize, LDS_BYTES);
        hipOccupancyMaxActiveBlocksPerMultiprocessor(&per_cu, (const void*)fwd_kernel, 512, LDS_BYTES);
        if (per_cu < 1) { fprintf(stderr, "kernel_launch: occupancy query says %d blocks/CU\n", per_cu); per_cu = 1; }
        grid_blocks = cus;
    }
    if (n_in != 28 || ws_size < WS_END) { fprintf(stderr, "kernel_launch: bad args n_in %d ws %zu need %zu\n", n_in, ws_size, (size_t)WS_END); return; }
    hipMemsetAsync((char*)d_ws + WS_BAR, 0, 16384, stream);
    Params p{};
    for (int i = 0; i < 28; ++i) p.in[i] = (const float*)d_in[i];
    p.out = (float*)d_out; p.ws = (unsigned char*)d_ws;
    void* args[] = {&p};
    hipError_t e = hipLaunchCooperativeKernel((const void*)fwd_kernel, dim3(grid_blocks), dim3(512), args, LDS_BYTES, stream);
    if (e != hipSuccess) fprintf(stderr, "cooperative launch failed: %s (grid %d)\n", hipGetErrorString(e), grid_blocks);
}
```

```cpp
#include <hip/hip_runtime.h>
#include <hip/hip_cooperative_groups.h>
#include <cstdio>
#include <cstdint>
namespace cg = cooperative_groups;
#ifndef PROBE_DUP
#define PROBE_DUP 0
#endif

#define DI __device__ __forceinline__
#define LAS __attribute__((address_space(3)))
typedef short bf16x8 __attribute__((ext_vector_type(8)));
typedef float f32x16 __attribute__((ext_vector_type(16)));
typedef float f32x4 __attribute__((ext_vector_type(4)));
typedef float f32x2 __attribute__((ext_vector_type(2)));
typedef unsigned u32x4 __attribute__((ext_vector_type(4)));
typedef unsigned u32x2 __attribute__((ext_vector_type(2)));
typedef __bf16 bf16x2_t __attribute__((ext_vector_type(2)));
typedef unsigned short bf16_t;

constexpr int NB = 4, SEQ = 4096, CTX = 256, T = SEQ + CTX, M = NB * T, D = 1024, DFF = 4096, NIN = 3072, NGRP = 18;
constexpr float EPS = 1e-6f, LOG2E = 1.4426950408889634f;

constexpr size_t WS_BAR = 0;
constexpr size_t WS_TAB = 16384;
constexpr size_t WS_MOD = 65536;
constexpr size_t WS_CTXB = 327680;
constexpr size_t WS_W = WS_CTXB + 4194304;
constexpr size_t W_IN_OFF = 0, W_OUT_OFF = 6291456, W_1_OFF = 8388608, W_2_OFF = 16777216;
constexpr size_t WS_ACT = WS_W + 25165824;
constexpr size_t WS_KV = WS_ACT + 35651584;
constexpr size_t WS_SIN = WS_KV + 17825792;
constexpr size_t WS_QKV = WS_SIN + 8912896;
constexpr size_t WS_VT = WS_QKV + 106954752;
constexpr size_t WS_KFB = WS_VT + 40108032;
constexpr size_t WS_KG8 = WS_KFB + 8912896;
constexpr size_t WS_END = WS_KG8 + 13369344;

constexpr int LDS_PITCH = 80, STAGE_MAT = 256 * LDS_PITCH, LDS_MAIN = 128 * 260 * 4, LDS_BYTES = LDS_MAIN + 256;

struct Params { const float* in[28]; float* out; unsigned char* ws; };

DI unsigned pk2(float a, float b) { f32x2 v = {a, b}; bf16x2_t r = __builtin_convertvector(v, bf16x2_t); return __builtin_bit_cast(unsigned, r); }
DI bf16x8 pack8(float a0, float a1, float a2, float a3, float a4, float a5, float a6, float a7) {
    u32x4 p = {pk2(a0, a1), pk2(a2, a3), pk2(a4, a5), pk2(a6, a7)}; return __builtin_bit_cast(bf16x8, p);
}
DI f32x16 mfma(bf16x8 a, bf16x8 b, f32x16 c) { return __builtin_amdgcn_mfma_f32_32x32x16_bf16(a, b, c, 0, 0, 0); }
DI f32x16 zero16() { f32x16 z; for (int i = 0; i < 16; ++i) z[i] = 0.f; return z; }
DI float ex2(float x) { return __builtin_amdgcn_exp2f(x); }
DI bf16x8 ldg8(const bf16_t* p) { return *(const bf16x8*)p; }
DI int crow(int i, int h) { return (i & 3) + 8 * (i >> 2) + 4 * h; }
DI int keyperm(int r) { const int a = r >> 3, g = (r >> 2) & 1, c = r & 3; return (a >> 1) * 16 + g * 8 + (a & 1) * 4 + c; }
DI int kidx(int i, int h) { return (i >> 3) * 16 + h * 8 + (i & 7); }
DI float bf2f(unsigned short u) { return __uint_as_float(((unsigned)u) << 16); }
DI int otid() { int t = threadIdx.x; asm volatile("" : "+v"(t)); return t; }
DI void stwt16(void* p, bf16x8 v) { asm volatile("global_store_dwordx4 %0, %1, off sc1\n\ts_nop 1" :: "v"(p), "v"(v) : "memory"); }
DI float wave_sum(float v) { for (int o = 32; o > 0; o >>= 1) v += __shfl_xor(v, o); return v; }

#define XB_TMO      128
#define XB_XCNT(j)  (256  + 64 * (j))
#define XB_XSUB(j)  (1280 + 64 * (j))
#define XB_XGEN(j)  (2304 + 64 * (j))
#define XB_TOP      3328
#define XB_TOPGEN   3392
#define XCD_BAR_WORDS 3456
#define XB_SPIN_CAP (1u << 22)
DI unsigned xb_ld(unsigned* p) { return __hip_atomic_load(p, __ATOMIC_RELAXED, __HIP_MEMORY_SCOPE_AGENT); }
DI unsigned xb_add(unsigned* p, unsigned v) { return __hip_atomic_fetch_add(p, v, __ATOMIC_RELAXED, __HIP_MEMORY_SCOPE_AGENT); }
DI unsigned xb_xcc_id() { return (unsigned)__builtin_amdgcn_s_getreg((3 << 11) | 20) & 0xFu; }
#define XB_SPIN(cond, bar) do { unsigned _sp = 0; while (cond) { __builtin_amdgcn_s_sleep(1); \
    if ((++_sp & 255u) == 0u) { if (xb_ld(&(bar)[XB_TMO])) break; if (_sp > XB_SPIN_CAP) { atomicAdd(&(bar)[XB_TMO], 1u); break; } } } } while (0)
struct XcdBarrier { unsigned* bar; unsigned x; volatile LAS unsigned* st; };
DI XcdBarrier xcd_barrier_post(unsigned* bar, volatile LAS unsigned* st) {
    XcdBarrier b; b.bar = bar; b.x = xb_xcc_id(); b.st = st;
    if (threadIdx.x == 0) (void)xb_add(&bar[XB_XCNT(b.x)], 1u);
    return b;
}
DI void xcd_barrier_complete(unsigned* bar, unsigned x, unsigned& nloc, unsigned& nx) {
    const unsigned G = gridDim.x * gridDim.y * gridDim.z;
    unsigned sum, cnt, mine, sp = 0u;
    for (;;) {
        sum = 0u; cnt = 0u; mine = 0u;
#pragma unroll
        for (unsigned j = 0; j < 16; ++j) { const unsigned c = xb_ld(&bar[XB_XCNT(j)]); sum += c; cnt += (c > 0u) ? 1u : 0u; mine = (j == x) ? c : mine; }
        if (sum == G) break;
        __builtin_amdgcn_s_sleep(1);
        if ((++sp & 255u) == 0u) { if (xb_ld(&bar[XB_TMO])) break; if (sp > XB_SPIN_CAP) { atomicAdd(&bar[XB_TMO], 1u); break; } }
    }
    nloc = mine > 0u ? mine : 1u; nx = cnt > 0u ? cnt : 1u;
}
DI void xcd_barrier(const XcdBarrier& b) {
    asm volatile("s_waitcnt vmcnt(0)" ::: "memory");
    __syncthreads();
    if (threadIdx.x == 0) {
        unsigned* bar = b.bar;
        __builtin_amdgcn_s_waitcnt(0);
        unsigned nloc = b.st[0], nx = b.st[1];
        const unsigned old = xb_add(&bar[XB_XSUB(b.x)], 1u);
        const unsigned gen = old / nloc;
        if (old + 1u == (gen + 1u) * nloc) {
            __builtin_amdgcn_fence(__ATOMIC_RELEASE, "agent");
            asm volatile("s_waitcnt vmcnt(0)" ::: "memory");
            const unsigned og = xb_add(&bar[XB_TOP], 1u);
            const unsigned tg = og / nx;
            if (og + 1u == (tg + 1u) * nx) xb_add(&bar[XB_TOPGEN], 1u);
            else XB_SPIN(xb_ld(&bar[XB_TOPGEN]) == tg, bar);
            __builtin_amdgcn_fence(__ATOMIC_ACQUIRE, "agent");
            xb_add(&bar[XB_XGEN(b.x)], 1u);
            asm volatile("s_waitcnt vmcnt(0)" ::: "memory");
        } else {
            __builtin_amdgcn_fence(__ATOMIC_ACQUIRE, "agent");
            asm volatile("s_waitcnt vmcnt(0)" ::: "memory");
            XB_SPIN(xb_ld(&bar[XB_XGEN(b.x)]) == gen, bar);
        }
    }
    __syncthreads();
}

DI void sincos_acc(float xf, float& s, float& c) {
    const double x = (double)xf;
    const double n = rint(x * 0.6366197723675814);
    const double rr = x - n * 1.5707963267948966;
    const double r2 = rr * rr;
    const double sp = rr * (1.0 + r2 * (-1.0 / 6 + r2 * (1.0 / 120 + r2 * (-1.0 / 5040 + r2 * (1.0 / 362880 + r2 * (-1.0 / 39916800 + r2 * (1.0 / 6227020800.0)))))));
    const double cp = 1.0 + r2 * (-0.5 + r2 * (1.0 / 24 + r2 * (-1.0 / 720 + r2 * (1.0 / 40320 + r2 * (-1.0 / 3628800 + r2 * (1.0 / 479001600 + r2 * (-1.0 / 87178291200.0)))))));
    const int q = ((int)n) & 3;
    const double ss = (q == 0) ? sp : (q == 1) ? cp : (q == 2) ? -sp : -cp;
    const double cc = (q == 0) ? cp : (q == 1) ? -sp : (q == 2) ? -cp : sp;
    s = (float)ss; c = (float)cc;
}

__device__ void prep_tables(const Params& p) {
    float* tab = (float*)(p.ws + WS_TAB);
    const int tid = otid();
    for (int idx = tid; idx < 1536; idx += 512) {
        int pos, i; float freq;
        if (idx < 1024) { pos = idx >> 4; i = idx & 15; freq = exp2f(-(float)i * (13.287712379549449f / 16.f)); }
        else { const int j = idx - 1024; pos = j >> 3; i = j & 7; freq = exp2f(-(float)i * (13.287712379549449f / 8.f)); }
        const float ang = (float)pos * freq;
        float s, c; sincos_acc(ang, s, c);
        if (idx < 1024) { tab[idx] = c; tab[1024 + idx] = s; }
        else { tab[2048 + (idx - 1024)] = c; tab[2560 + (idx - 1024)] = s; }
    }
    if (tid < 128) {
        const int l = tid >> 6, lane = tid & 63;
        float* cst = tab + 3072 + l * 32;
        float s1 = 0.f, s2 = 0.f;
        if (lane < 32) { s1 = p.in[15][l * 32 + lane] * p.in[16][l * 32 + lane]; s2 = p.in[17][l * 32 + lane] * p.in[18][l * 32 + lane]; }
        s1 = wave_sum(s1); s2 = wave_sum(s2);
        float maq = fabsf(p.in[10][l * 64 + lane]), mak = fabsf(p.in[11][l * 64 + lane]), mdq = fabsf(p.in[23][l * 64 + lane]), mdk = fabsf(p.in[24][l * 64 + lane]);
        float mbq = fabsf(p.in[13][l * 32 + (lane & 31)]), mbk = fabsf(p.in[14][l * 32 + (lane & 31)]);
        float mr = 0.f;
        for (int i = lane; i < 4 * 465; i += 64) mr = fmaxf(mr, fabsf(p.in[25][l * 1860 + i]));
        for (int o = 32; o > 0; o >>= 1) {
            maq = fmaxf(maq, __shfl_xor(maq, o)); mak = fmaxf(mak, __shfl_xor(mak, o)); mdq = fmaxf(mdq, __shfl_xor(mdq, o)); mdk = fmaxf(mdk, __shfl_xor(mdk, o));
            mbq = fmaxf(mbq, __shfl_xor(mbq, o)); mbk = fmaxf(mbk, __shfl_xor(mbk, o)); mr = fmaxf(mr, __shfl_xor(mr, o));
        }
        if (lane == 0) {
            const float li = 0.8f - 0.6f * expf(-0.3f * (float)l);
            cst[0] = expf(s1) - expf(s2) + li;
            cst[1] = 1.f - li;
            cst[2] = 8.f * maq * mak * LOG2E;
            cst[3] = 5.656854249492381f * mbq * mbk * LOG2E;
            cst[4] = (8.f * mdq * mdk + mr) * LOG2E;
        }
        if (lane < 4) {
            cst[8 + lane] = -log1pf(expf(-p.in[20][l * 4 + lane])) * LOG2E;
            cst[12 + lane] = -log1pf(expf(-p.in[21][l * 4 + lane])) * LOG2E;
            cst[16 + lane] = p.in[12][l * 4 + lane] * LOG2E;
        }
    }
}

__device__ void mod_item(const Params& p, int item, unsigned char* lds) {
    float* sv = (float*)lds;
    float* red = sv + 5 * 1024;
    const int tid = otid(), l = item / 96, n0 = (item % 96) * 64;
    for (int idx = tid; idx < 5 * 1024; idx += 512) {
        const int j = idx >> 10, k = idx & 1023;
        const float c = (j < 4) ? p.in[1][j * 1024 + k] : p.in[3][k];
        sv[idx] = c / (1.f + expf(-c));
    }
    __syncthreads();
    const int col = tid & 63, kg = tid >> 6;
    const float* w = p.in[4] + (size_t)l * 1024 * 6144 + (size_t)(kg * 128) * 6144 + n0 + col;
    float a0 = 0.f, a1 = 0.f, a2 = 0.f, a3 = 0.f, a4 = 0.f;
#pragma unroll 16
    for (int k = 0; k < 128; ++k) {
        const float wv = w[(size_t)k * 6144];
        const int kk = kg * 128 + k;
        a0 += sv[kk] * wv; a1 += sv[1024 + kk] * wv; a2 += sv[2048 + kk] * wv; a3 += sv[3072 + kk] * wv; a4 += sv[4096 + kk] * wv;
    }
    red[(kg * 5 + 0) * 64 + col] = a0; red[(kg * 5 + 1) * 64 + col] = a1; red[(kg * 5 + 2) * 64 + col] = a2;
    red[(kg * 5 + 3) * 64 + col] = a3; red[(kg * 5 + 4) * 64 + col] = a4;
    __syncthreads();
    if (tid < 320) {
        const int j = tid >> 6, c = tid & 63;
        float s = p.in[5][l * 6144 + n0 + c];
        for (int g = 0; g < 8; ++g) s += red[(g * 5 + j) * 64 + c];
        ((float*)(p.ws + WS_MOD))[(l * 5 + j) * 6144 + n0 + c] = s;
    }
    __syncthreads();
}

__device__ void conv_layer(const Params& p, int l, unsigned char* lds, int lo, int hi, int bfirst, int nblk) {
    const int tid = otid(), grp = tid >> 7, t = tid & 127;
    float* tl = (float*)lds + grp * (64 * 65);
    bf16_t* wb = (bf16_t*)(p.ws + WS_W);
    if ((int)blockIdx.x < bfirst || (int)blockIdx.x >= bfirst + nblk) return;
    for (int it0 = lo + ((int)blockIdx.x - bfirst) * 4; it0 < hi; it0 += nblk * 4) {
        const int it = it0 + grp;
        const float* W; bf16_t* WT; int K, N, tile;
        if (it < 768) { W = p.in[8] + (size_t)l * 1024 * 3072; WT = (bf16_t*)((unsigned char*)wb + W_IN_OFF); K = 1024; N = 3072; tile = it; }
        else if (it < 1024) { W = p.in[9] + (size_t)l * 1024 * 1024; WT = (bf16_t*)((unsigned char*)wb + W_OUT_OFF); K = 1024; N = 1024; tile = it - 768; }
        else if (it < 2048) { W = p.in[26] + (size_t)l * 1024 * 4096; WT = (bf16_t*)((unsigned char*)wb + W_1_OFF); K = 1024; N = 4096; tile = it - 1024; }
        else { W = p.in[27] + (size_t)l * 4096 * 1024; WT = (bf16_t*)((unsigned char*)wb + W_2_OFF); K = 4096; N = 1024; tile = it - 2048; }
        const int nkt = K / 64, kt = tile % nkt, nt = tile / nkt, k0 = kt * 64, n0 = nt * 64;
        f32x4 v[8];
#pragma unroll
        for (int i = 0; i < 8; ++i) { const int idx = t + i * 128, k = idx >> 4, c4 = idx & 15; v[i] = *(const f32x4*)(W + (size_t)(k0 + k) * N + n0 + c4 * 4); }
#pragma unroll
        for (int i = 0; i < 8; ++i) { const int idx = t + i * 128, k = idx >> 4, c4 = idx & 15;
            tl[k * 65 + c4 * 4 + 0] = v[i][0]; tl[k * 65 + c4 * 4 + 1] = v[i][1]; tl[k * 65 + c4 * 4 + 2] = v[i][2]; tl[k * 65 + c4 * 4 + 3] = v[i][3]; }
        __syncthreads();
#pragma unroll
        for (int i = 0; i < 4; ++i) {
            const int idx = t + i * 128, n = idx >> 3, kc = idx & 7;
            float w[8];
#pragma unroll
            for (int j = 0; j < 8; ++j) w[j] = tl[(kc * 8 + j) * 65 + n];
            *(bf16x8*)(WT + (size_t)(n0 + n) * K + k0 + kc * 8) = pack8(w[0], w[1], w[2], w[3], w[4], w[5], w[6], w[7]);
        }
        __syncthreads();
    }
}

__device__ void norm_phase(const float* lat, const float* ctxb, const float* g, const float* mod, int shoff, int scoff, bf16_t* act, bool skip_ctx,
                           const float* slab = nullptr, int nsplit = 0, const float* gatec = nullptr, float* ctx_wb = nullptr, const float* slab2 = nullptr) {
    const int tid = otid(), lane = tid & 63, gw = blockIdx.x * 8 + (tid >> 6), nw = gridDim.x * 8;
    f32x4 gg[4], sh[4], sc[4], v[4], nx[4];
#pragma unroll
    for (int i = 0; i < 4; ++i) gg[i] = *(const f32x4*)(g + i * 256 + lane * 4);
    if (!skip_ctx) {
        const float* mj = mod + 4 * 6144;
        bool have = false;
        for (int cr = gw; cr < NB * CTX; cr += nw) {
            const int b = cr >> 8, t = cr & 255, R = b * T + t;
            if (!have) {
                have = true;
#pragma unroll
                for (int i = 0; i < 4; ++i) { sh[i] = *(const f32x4*)(mj + shoff + i * 256 + lane * 4); sc[i] = *(const f32x4*)(mj + scoff + i * 256 + lane * 4); }
            }
#pragma unroll
            for (int i = 0; i < 4; ++i) v[i] = *(const f32x4*)(ctxb + (size_t)cr * D + i * 256 + lane * 4);
            if (nsplit > 0) {
#pragma unroll
                for (int i = 0; i < 4; ++i) {
                    f32x4 acc = {0.f, 0.f, 0.f, 0.f};
                    for (int sp = 0; sp < nsplit; ++sp) { const f32x4 pv = *(const f32x4*)((sp < 4 ? slab : slab2) + ((size_t)(((sp & 3) * 16 + b * 4 + i) * 256 + t)) * 256 + lane * 4); acc += pv; }
                    const f32x4 gt = *(const f32x4*)(gatec + i * 256 + lane * 4);
                    v[i] += gt * acc;
                    if (ctx_wb) *(f32x4*)(ctx_wb + (size_t)cr * D + i * 256 + lane * 4) = v[i];
                }
            }
            float ss = 0.f;
#pragma unroll
            for (int i = 0; i < 4; ++i) ss += v[i][0] * v[i][0] + v[i][1] * v[i][1] + v[i][2] * v[i][2] + v[i][3] * v[i][3];
            ss = wave_sum(ss);
            const float rstd = rsqrtf(ss * (1.f / 1024.f) + EPS);
#pragma unroll
            for (int i = 0; i < 4; ++i) {
                float y[4];
#pragma unroll
                for (int e = 0; e < 4; ++e) y[e] = v[i][e] * rstd * gg[i][e] * (1.f + sc[i][e]) + sh[i][e];
                u32x2 o = {pk2(y[0], y[1]), pk2(y[2], y[3])};
                *(u32x2*)(act + (size_t)R * D + i * 256 + lane * 4) = o;
            }
        }
    }
    const int per = (NB * SEQ + nw - 1) / nw;
    int Rl = gw * per; const int Rend = min(NB * SEQ, Rl + per);
    if (Rl >= Rend) return;
    int curb = -1;
#pragma unroll
    for (int i = 0; i < 4; ++i) v[i] = __builtin_nontemporal_load((const f32x4*)(lat + (size_t)Rl * D + i * 256 + lane * 4));
    for (; Rl < Rend; ++Rl) {
        if (Rl + 1 < Rend) {
#pragma unroll
            for (int i = 0; i < 4; ++i) nx[i] = __builtin_nontemporal_load((const f32x4*)(lat + (size_t)(Rl + 1) * D + i * 256 + lane * 4));
        }
        const int b = Rl >> 12, R = b * T + CTX + (Rl & 4095);
        if (b != curb) {
            curb = b;
            const float* mj = mod + b * 6144;
#pragma unroll
            for (int i = 0; i < 4; ++i) { sh[i] = *(const f32x4*)(mj + shoff + i * 256 + lane * 4); sc[i] = *(const f32x4*)(mj + scoff + i * 256 + lane * 4); }
        }
        float ss = 0.f;
#pragma unroll
        for (int i = 0; i < 4; ++i) ss += v[i][0] * v[i][0] + v[i][1] * v[i][1] + v[i][2] * v[i][2] + v[i][3] * v[i][3];
        ss = wave_sum(ss);
        const float rstd = rsqrtf(ss * (1.f / 1024.f) + EPS);
#pragma unroll
        for (int i = 0; i < 4; ++i) {
            float y[4];
#pragma unroll
            for (int e = 0; e < 4; ++e) y[e] = v[i][e] * rstd * gg[i][e] * (1.f + sc[i][e]) + sh[i][e];
            u32x2 o = {pk2(y[0], y[1]), pk2(y[2], y[3])};
            *(u32x2*)(act + (size_t)R * D + i * 256 + lane * 4) = o;
        }
#pragma unroll
        for (int i = 0; i < 4; ++i) v[i] = nx[i];
    }
}

struct EpiArgs {
    const float* lat_in; const float* ctx_in; float* lat_out; float* ctx_out; const float* gate;
    bf16_t* out; int ldo;
    bf16_t* vt; bf16_t* kfb; bf16_t* kg8; unsigned* kvcnt; const float* aq; const float* ak; const float* bq; const float* bk; const float* dq; const float* dk; const float* tab;
};
enum { EPI_RESID = 0, EPI_RELU2 = 1, EPI_INPROJ = 2 };

DI void inproj_slab(const EpiArgs& ea, int cgi, const float* st, int Rbase, int lane) {
    int kind; const float* g = nullptr; float scale = 1.f; int vt_grp = -1;
    if (cgi < 4) { kind = 0; g = ea.aq; scale = 0.125f * LOG2E; }
    else if (cgi < 6) { kind = 0; g = ea.ak; }
    else if (cgi < 8) { kind = 5; vt_grp = cgi - 6; }
    else if (cgi < 12) { kind = 1; g = ea.bq; scale = 0.17677669529663687f * LOG2E; }
    else if (cgi < 16) { kind = 1; g = ea.bk; }
    else if (cgi < 20) { kind = 5; vt_grp = 2 + cgi - 16; }
    else if (cgi < 24) { kind = 3; }
    else if (cgi < 28) { kind = 3; scale = 0.125f; vt_grp = 14 + cgi - 24; }
    else if (cgi < 32) { kind = 5; vt_grp = 6 + cgi - 28; }
    else if (cgi < 36) { kind = 4; }
    else if (cgi < 40) { kind = 2; g = ea.dq; scale = 0.125f * LOG2E; }
    else if (cgi < 44) { kind = 2; g = ea.dk; }
    else { kind = 5; vt_grp = 10 + cgi - 44; }

    if (kind != 5) {
        const int row = lane >> 1, half = lane & 1, R = Rbase + row, b = R / T, t = R - b * T;
        const bool lat = t >= CTX; const int pos = t - CTX, pr = pos >> 6, pc = pos & 63;
        float v[32];
#pragma unroll
        for (int j = 0; j < 8; ++j) { const f32x4 q = *(const f32x4*)(st + row * 68 + half * 32 + j * 4); v[4 * j] = q[0]; v[4 * j + 1] = q[1]; v[4 * j + 2] = q[2]; v[4 * j + 3] = q[3]; }
        if (kind == 0 || kind == 2) {
            float ss = 0.f;
#pragma unroll
            for (int i = 0; i < 32; ++i) ss += v[i] * v[i];
            ss += __shfl_xor(ss, 1);
            const float rstd = rsqrtf(ss * (1.f / 64.f) + EPS);
#pragma unroll
            for (int i = 0; i < 32; ++i) v[i] *= rstd * g[half * 32 + i];
            if (kind == 0 && lat) {
                const int pp = half ? pc : pr;
                const float* tc = ea.tab + pp * 16; const float* ts = ea.tab + 1024 + pp * 16;
#pragma unroll
                for (int i = 0; i < 16; ++i) { const float c = tc[i], s = ts[i], x1 = v[i], x2 = v[i + 16]; v[i] = x1 * c - x2 * s; v[i + 16] = x1 * s + x2 * c; }
            }
        } else if (kind == 1) {
            float ss = 0.f;
#pragma unroll
            for (int i = 0; i < 32; ++i) ss += v[i] * v[i];
            const float rstd = rsqrtf(ss * (1.f / 32.f) + EPS);
#pragma unroll
            for (int i = 0; i < 32; ++i) v[i] *= rstd * g[i];
            if (lat) {
                const float* tcr = ea.tab + 2048 + pr * 8; const float* tsr = ea.tab + 2560 + pr * 8;
                const float* tcc = ea.tab + 2048 + pc * 8; const float* tsc = ea.tab + 2560 + pc * 8;
#pragma unroll
                for (int i = 0; i < 8; ++i) {
                    { const float c = tcr[i], s = tsr[i], x1 = v[i], x2 = v[i + 8]; v[i] = x1 * c - x2 * s; v[i + 8] = x1 * s + x2 * c; }
                    { const float c = tcc[i], s = tsc[i], x1 = v[16 + i], x2 = v[24 + i]; v[16 + i] = x1 * c - x2 * s; v[24 + i] = x1 * s + x2 * c; }
                }
            }
        } else if (kind == 4) {
#pragma unroll
            for (int i = 0; i < 32; ++i) v[i] = v[i] / (1.f + __expf(-v[i]));
        }
        bf16_t* dst = ea.out + (size_t)R * NIN + cgi * 64 + half * 32;
#pragma unroll
        for (int j = 0; j < 4; ++j)
            *(bf16x8*)(dst + j * 8) = pack8(v[8 * j] * scale, v[8 * j + 1] * scale, v[8 * j + 2] * scale, v[8 * j + 3] * scale, v[8 * j + 4] * scale, v[8 * j + 5] * scale, v[8 * j + 6] * scale, v[8 * j + 7] * scale);
    }
    if (vt_grp >= 0) {
        const int b = Rbase / T, t0 = Rbase - b * T;
        float v[32];
#pragma unroll
        for (int rr = 0; rr < 32; ++rr) v[rr] = st[rr * 68 + lane] * scale;
        bf16_t* dst = ea.vt + ((size_t)(b * NGRP + vt_grp) * 64 + lane) * T + t0;
#pragma unroll
        for (int j = 0; j < 4; ++j)
            *(bf16x8*)(dst + j * 8) = pack8(v[8 * j], v[8 * j + 1], v[8 * j + 2], v[8 * j + 3], v[8 * j + 4], v[8 * j + 5], v[8 * j + 6], v[8 * j + 7]);
    }
}

template <int EPI>
__device__ void gemm_phase(const bf16_t* __restrict__ A, const bf16_t* __restrict__ Bt, int K, int N, const EpiArgs& ea, unsigned char* lds, bool skip_ctx) {
    const int tid = otid(), wid = tid >> 6, lane = tid & 63, r = lane & 31, h = lane >> 5, wr = wid >> 2, wc = wid & 3;
    const int nN = N / 256, ntiles = 68 * nN, nk = K / 32;
    const int lrow = tid >> 2, lkc = tid & 3;
    for (int tile = blockIdx.x; tile < ntiles; tile += gridDim.x) {
        const int pm = tile % 68, pn = tile / 68;
        if (skip_ctx && (pm % 17 == 0)) continue;
        const int m0 = pm * 256, n0 = pn * 256;
        f32x16 acc[4][2];
#pragma unroll
        for (int i = 0; i < 4; ++i) { acc[i][0] = zero16(); acc[i][1] = zero16(); }
        const bf16_t* ga = A + (size_t)(m0 + lrow) * K + lkc * 8;
        const bf16_t* gb = Bt + (size_t)(n0 + lrow) * K + lkc * 8;
        const int loff = lrow * LDS_PITCH + lkc * 16;
        u32x4 ra[2], rb[2];
#pragma unroll
        for (int i = 0; i < 2; ++i) { ra[i] = *(const u32x4*)(ga + (size_t)i * 128 * K); rb[i] = *(const u32x4*)(gb + (size_t)i * 128 * K); }
#pragma unroll
        for (int i = 0; i < 2; ++i) { *(u32x4*)(lds + loff + i * 128 * LDS_PITCH) = ra[i]; *(u32x4*)(lds + STAGE_MAT + loff + i * 128 * LDS_PITCH) = rb[i]; }
        __syncthreads();
#pragma unroll
        for (int i = 0; i < 2; ++i) { ra[i] = *(const u32x4*)(ga + (size_t)i * 128 * K + 32); rb[i] = *(const u32x4*)(gb + (size_t)i * 128 * K + 32); }
#pragma unroll 1
        for (int kt = 0; kt < nk; ++kt) {
            const unsigned char* sa = lds + (kt & 1) * 2 * STAGE_MAT;
            const unsigned char* sb = sa + STAGE_MAT;
#pragma unroll
            for (int ks = 0; ks < 2; ++ks) {
                bf16x8 af[4], bfr[2];
#pragma unroll
                for (int mb = 0; mb < 4; ++mb) af[mb] = *(const bf16x8*)(sa + (wr * 128 + mb * 32 + r) * LDS_PITCH + ks * 32 + h * 16);
#pragma unroll
                for (int nb = 0; nb < 2; ++nb) bfr[nb] = *(const bf16x8*)(sb + (wc * 64 + nb * 32 + r) * LDS_PITCH + ks * 32 + h * 16);
#pragma unroll
                for (int mb = 0; mb < 4; ++mb)
#pragma unroll
                    for (int nb = 0; nb < 2; ++nb) acc[mb][nb] = mfma(af[mb], bfr[nb], acc[mb][nb]);
            }
            if (kt + 1 < nk) {
                unsigned char* da = lds + ((kt + 1) & 1) * 2 * STAGE_MAT;
#pragma unroll
                for (int i = 0; i < 2; ++i) { *(u32x4*)(da + loff + i * 128 * LDS_PITCH) = ra[i]; *(u32x4*)(da + STAGE_MAT + loff + i * 128 * LDS_PITCH) = rb[i]; }
            }
            __syncthreads();
            if (kt + 2 < nk) {
#pragma unroll
                for (int i = 0; i < 2; ++i) { ra[i] = *(const u32x4*)(ga + (size_t)i * 128 * K + (kt + 2) * 32); rb[i] = *(const u32x4*)(gb + (size_t)i * 128 * K + (kt + 2) * 32); }
            }
        }
        {
            float* st = (float*)(lds + wid * 8704);
            const int cgi = (n0 + wc * 64) >> 6;
#pragma unroll
            for (int mb = 0; mb < 4; ++mb) {
                __syncthreads();
#pragma unroll
                for (int nb = 0; nb < 2; ++nb)
#pragma unroll
                    for (int i = 0; i < 16; ++i) st[crow(i, h) * 68 + nb * 32 + r] = acc[mb][nb][i];
                __syncthreads();
                const int Rbase = m0 + wr * 128 + mb * 32;
                if (EPI == EPI_INPROJ) inproj_slab(ea, cgi, st, Rbase, lane);
                else if (EPI == EPI_RESID) {
                    const int row = lane >> 1, half = lane & 1;
                    const int b = pm / 17, tt = pm % 17;
                    const float* gate = ea.gate + ((tt == 0) ? 4 : b) * 6144 + n0 + wc * 64 + half * 32;
                    const int trow = wr * 128 + mb * 32 + row;
                    size_t o;
                    const float* rin; float* rout;
                    if (tt == 0) { o = ((size_t)b * CTX + trow) * D; rin = ea.ctx_in; rout = ea.ctx_out; }
                    else { o = ((size_t)b * SEQ + (size_t)(tt - 1) * 256 + trow) * D; rin = ea.lat_in; rout = ea.lat_out; }
                    o += n0 + wc * 64 + half * 32;
#pragma unroll
                    for (int j = 0; j < 8; ++j) {
                        const f32x4 q = *(const f32x4*)(st + row * 68 + half * 32 + j * 4);
                        const f32x4 gv = *(const f32x4*)(gate + j * 4);
                        const f32x4 xi = *(const f32x4*)(rin + o + j * 4);
                        f32x4 y; y[0] = xi[0] + gv[0] * q[0]; y[1] = xi[1] + gv[1] * q[1]; y[2] = xi[2] + gv[2] * q[2]; y[3] = xi[3] + gv[3] * q[3];
                        *(f32x4*)(rout + o + j * 4) = y;
                    }
                } else {
                    const int row = lane >> 1, half = lane & 1;
                    float v[32];
#pragma unroll
                    for (int j = 0; j < 8; ++j) { const f32x4 q = *(const f32x4*)(st + row * 68 + half * 32 + j * 4); v[4 * j] = q[0]; v[4 * j + 1] = q[1]; v[4 * j + 2] = q[2]; v[4 * j + 3] = q[3]; }
#pragma unroll
                    for (int i = 0; i < 32; ++i) { const float x = fmaxf(v[i], 0.f); v[i] = x * x; }
                    bf16_t* dst = ea.out + (size_t)(Rbase + row) * ea.ldo + n0 + wc * 64 + half * 32;
#pragma unroll
                    for (int j = 0; j < 4; ++j)
                        *(bf16x8*)(dst + j * 8) = pack8(v[8 * j], v[8 * j + 1], v[8 * j + 2], v[8 * j + 3], v[8 * j + 4], v[8 * j + 5], v[8 * j + 6], v[8 * j + 7]);
                }
            }
            __syncthreads();
        }
    }
}

namespace g8 {
constexpr int BM = 256, BK = 64, HALF = 128, HT = HALF * BK, SPITCH = 260;
DI int lds_byte(int r, int c) { const int st = (r >> 4) * 2 + (c >> 5), rr = r & 15, cc = c & 31, ob = rr * 64 + cc * 2; return st * 1024 + (ob ^ (((ob >> 9) & 1) << 5)); }
DI void stage_rc(int b, int& R, int& C) { const int st = b / 1024, sb = b % 1024, swz = sb ^ (((sb >> 9) & 1) << 5); R = (st >> 1) * 16 + swz / 64; C = (st & 1) * 32 + (swz % 64) / 2; }
}

DI void inproj_pass(const EpiArgs& ea, LAS float* st, int cgl, int cgi, int rw  , int lane, int Rtile  ) {
    int kind; const float* g = nullptr; float scale = 1.f; int vt_grp = -1;
    if (cgi < 4) { kind = 0; g = ea.aq; scale = 0.125f * LOG2E; }
    else if (cgi < 6) { kind = 0; g = ea.ak; }
    else if (cgi < 8) { kind = 5; vt_grp = cgi - 6; }
    else if (cgi < 12) { kind = 1; g = ea.bq; scale = 0.17677669529663687f * LOG2E; }
    else if (cgi < 16) { kind = 1; g = ea.bk; }
    else if (cgi < 20) { kind = 5; vt_grp = 2 + cgi - 16; }
    else if (cgi < 24) { kind = 3; }
    else if (cgi < 28) { kind = 3; scale = 0.125f; vt_grp = 14 + cgi - 24; }
    else if (cgi < 32) { kind = 5; vt_grp = 6 + cgi - 28; }
    else if (cgi < 36) { kind = 4; }
    else if (cgi < 40) { kind = 2; g = ea.dq; scale = 0.125f * LOG2E; }
    else if (cgi < 44) { kind = 2; g = ea.dk; }
    else { kind = 5; vt_grp = 10 + cgi - 44; }
    if (vt_grp >= 0) {
        const int R0 = Rtile + rw * 64, b = R0 / T, t0 = R0 - b * T;
        bf16_t* dst = ea.vt + ((size_t)(b * NGRP + vt_grp) * 64 + lane) * T + t0;
#pragma unroll 1
        for (int hf = 0; hf < 2; ++hf) {
            float v[32];
#pragma unroll
            for (int rr = 0; rr < 32; ++rr) v[rr] = st[(rw * 64 + hf * 32 + rr) * g8::SPITCH + cgl * 64 + lane] * scale;
            if (vt_grp >= 2 && vt_grp < 6) {
                bf16_t* fd = ea.vt + (size_t)(b * NGRP + vt_grp) * 64 * T + (size_t)((t0 >> 5) + hf) * 2048 + (lane >> 5) * 1024 + (lane & 31) * 8;
#pragma unroll
                for (int j = 0; j < 4; ++j)
                    *(bf16x8*)(fd + (j >> 1) * 512 + (j & 1) * 256) = pack8(v[8 * j], v[8 * j + 1], v[8 * j + 2], v[8 * j + 3], v[8 * j + 4], v[8 * j + 5], v[8 * j + 6], v[8 * j + 7]);
            } else if (true) {
                bf16_t* fd = ea.vt + (size_t)(b * NGRP + vt_grp) * 64 * T + (size_t)((t0 >> 3) + hf * 4) * 512 + (lane >> 5) * 256 + (lane & 31) * 8;
#pragma unroll
                for (int j = 0; j < 4; ++j) {
                    const bf16x8 w8 = pack8(v[8 * j], v[8 * j + 1], v[8 * j + 2], v[8 * j + 3], v[8 * j + 4], v[8 * j + 5], v[8 * j + 6], v[8 * j + 7]);
                    if ((vt_grp >= 6 && vt_grp < 10) || vt_grp >= 14) stwt16(fd + j * 512, w8); else *(bf16x8*)(fd + j * 512) = w8;
                }
            } else {
#pragma unroll
                for (int j = 0; j < 4; ++j)
                    *(bf16x8*)(dst + hf * 32 + j * 8) = pack8(v[8 * j], v[8 * j + 1], v[8 * j + 2], v[8 * j + 3], v[8 * j + 4], v[8 * j + 5], v[8 * j + 6], v[8 * j + 7]);
            }
        }
    }
    if (vt_grp >= 0 && kind != 5) { asm volatile("s_waitcnt lgkmcnt(0)" ::: "memory"); __builtin_amdgcn_wave_barrier(); }
    if (kind != 5) {
        const int row = rw * 64 + lane, R = Rtile + row, b = R / T, t = R - b * T;
        const bool lat = t >= CTX; const int pos = t - CTX, pr = pos >> 6, pc = pos & 63;
        LAS float* srow = st + row * g8::SPITCH + cgl * 64;
        float ss64 = 0.f;
        if (kind == 0 || kind == 2) {
#pragma unroll
            for (int j = 0; j < 16; ++j) { const f32x4 q = *(const LAS f32x4*)(srow + j * 4); ss64 += q[0] * q[0] + q[1] * q[1] + q[2] * q[2] + q[3] * q[3]; }
        }
        const float rstd64 = rsqrtf(ss64 * (1.f / 64.f) + EPS);
        bf16_t* dst = ea.out + (size_t)R * NIN + cgi * 64;
#pragma unroll 1
        for (int hf = 0; hf < 2; ++hf) {
            float v[32];
#pragma unroll
            for (int j = 0; j < 8; ++j) { const f32x4 q = *(const LAS f32x4*)(srow + hf * 32 + j * 4); v[4 * j] = q[0]; v[4 * j + 1] = q[1]; v[4 * j + 2] = q[2]; v[4 * j + 3] = q[3]; }
            if (kind == 0 || kind == 2) {
#pragma unroll
                for (int i = 0; i < 32; ++i) v[i] *= rstd64 * g[hf * 32 + i];
                if (kind == 0 && lat) {
                    const int pp = hf ? pc : pr;
                    const float* tc = ea.tab + pp * 16; const float* ts = ea.tab + 1024 + pp * 16;
#pragma unroll
                    for (int i = 0; i < 16; ++i) { const float c = tc[i], sn = ts[i], x1 = v[i], x2 = v[i + 16]; v[i] = x1 * c - x2 * sn; v[i + 16] = x1 * sn + x2 * c; }
                }
            } else if (kind == 1) {
                float ss = 0.f;
#pragma unroll
                for (int i = 0; i < 32; ++i) ss += v[i] * v[i];
                const float rstd = rsqrtf(ss * (1.f / 32.f) + EPS);
#pragma unroll
                for (int i = 0; i < 32; ++i) v[i] *= rstd * g[i];
                if (lat) {
                    const float* tcr = ea.tab + 2048 + pr * 8; const float* tsr = ea.tab + 2560 + pr * 8;
                    const float* tcc = ea.tab + 2048 + pc * 8; const float* tsc = ea.tab + 2560 + pc * 8;
#pragma unroll
                    for (int i = 0; i < 8; ++i) {
                        { const float c = tcr[i], sn = tsr[i], x1 = v[i], x2 = v[i + 8]; v[i] = x1 * c - x2 * sn; v[i + 8] = x1 * sn + x2 * c; }
                        { const float c = tcc[i], sn = tsc[i], x1 = v[16 + i], x2 = v[24 + i]; v[16 + i] = x1 * c - x2 * sn; v[24 + i] = x1 * sn + x2 * c; }
                    }
                }
            } else if (kind == 4) {
#pragma unroll
                for (int i = 0; i < 32; ++i) v[i] = v[i] / (1.f + __expf(-v[i]));
            }
            if (cgi >= 12 && cgi < 16) {
                const int tile = t >> 5, kk = t & 31, rinv = ((kk >> 4) & 1) * 16 + ((kk >> 2) & 1) * 8 + ((kk >> 3) & 1) * 4 + (kk & 3);
                bf16_t* fd = ea.kfb + ((size_t)((b * 4 + (cgi - 12)) * 136 + tile)) * 2048 + hf * 1024 + rinv * 8;
#pragma unroll
                for (int j = 0; j < 4; ++j)
                    *(bf16x8*)(fd + (j >> 1) * 512 + (j & 1) * 256) = pack8(v[8 * j] * scale, v[8 * j + 1] * scale, v[8 * j + 2] * scale, v[8 * j + 3] * scale, v[8 * j + 4] * scale, v[8 * j + 5] * scale, v[8 * j + 6] * scale, v[8 * j + 7] * scale);
            } else if ((cgi >= 4 && cgi < 6) || (cgi >= 40 && cgi < 44)) {
                const int kh = (cgi < 6) ? (cgi - 4) : (2 + cgi - 40);
                bf16_t* fd = ea.kg8 + (size_t)(b * 6 + kh) * 64 * T + (size_t)(t >> 3) * 512 + hf * 256 + (t & 7) * 8;
#pragma unroll
                for (int j = 0; j < 4; ++j)
                    *(bf16x8*)(fd + (j >> 1) * 128 + (j & 1) * 64) = pack8(v[8 * j] * scale, v[8 * j + 1] * scale, v[8 * j + 2] * scale, v[8 * j + 3] * scale, v[8 * j + 4] * scale, v[8 * j + 5] * scale, v[8 * j + 6] * scale, v[8 * j + 7] * scale);
            } else {
                LAS bf16x8* seg = (LAS bf16x8*)srow;
#pragma unroll
                for (int j = 0; j < 4; ++j)
                    seg[hf * 4 + j] = pack8(v[8 * j] * scale, v[8 * j + 1] * scale, v[8 * j + 2] * scale, v[8 * j + 3] * scale, v[8 * j + 4] * scale, v[8 * j + 5] * scale, v[8 * j + 6] * scale, v[8 * j + 7] * scale);
            }
        }
        const bool tokmajor = !((cgi >= 12 && cgi < 16) || (cgi >= 4 && cgi < 6) || (cgi >= 40 && cgi < 44));
        if (tokmajor) {
            asm volatile("s_waitcnt lgkmcnt(0)" ::: "memory");
            __builtin_amdgcn_wave_barrier();
#pragma unroll
            for (int itr = 0; itr < 8; ++itr) {
                const int row_l = itr * 8 + (lane >> 3), chunk = lane & 7;
                const bf16x8 w = *(const LAS bf16x8*)((const LAS unsigned char*)(st + (rw * 64 + row_l) * g8::SPITCH + cgl * 64) + chunk * 16);
                *(bf16x8*)(ea.out + (size_t)(Rtile + rw * 64 + row_l) * NIN + cgi * 64 + chunk * 8) = w;
            }
        }
    }
}

template <int EPI>
__device__ void gemm_phase8(const bf16_t* __restrict__ A, const bf16_t* __restrict__ Bt, const int K, const int N, const EpiArgs& ea, unsigned char* lds, const bool skip_ctx, const int nsplit = 0, float* slab = nullptr, float* slab2 = nullptr) {
    using namespace g8;
    LAS unsigned char* ldsl = (LAS unsigned char*)lds;
    const int tidx = otid();
    const int wid = __builtin_amdgcn_readfirstlane(tidx >> 6), lane = tidx & 63, wr = wid >> 2, wc = wid & 3, fr = lane & 15, fq = lane >> 4;
    int sr0, sc0; stage_rc(tidx * 16, sr0, sc0);
    const unsigned gb0 = (unsigned)(sr0 * K + sc0) * 2u, gb1 = gb0 + 128u * (unsigned)K;
    const int aoff = lds_byte(wr * 64 + fr, fq * 8), boff = lds_byte(wc * 32 + fr, fq * 8);
    const unsigned ldsw = (unsigned)tidx * 16u;
#define SA(b, h) (((b) * 2 + (h)) * 16384)
#define SB(b, h) ((4 + (b) * 2 + (h)) * 16384)
#define STAGE(P, BASE, br, kt) do { const char* _sb = (const char*)(BASE + ((long)(br) * K + kbeg + (long)(kt) * BK)); \
    unsigned _g0 = gb0, _g1 = gb1; asm volatile("" : "+v"(_g0), "+v"(_g1)); \
    __builtin_amdgcn_global_load_lds((const unsigned*)(_sb + _g0), (LAS unsigned*)(ldsl + (P) + ldsw), 16, 0, 0); \
    __builtin_amdgcn_global_load_lds((const unsigned*)(_sb + _g1), (LAS unsigned*)(ldsl + (P) + ldsw + 8192), 16, 0, 0); } while (0)
#define LDA(dst, b, h) _Pragma("unroll") for (int m = 0; m < 4; ++m) _Pragma("unroll") for (int k = 0; k < 2; ++k) \
    dst[m][k] = *(const LAS bf16x8*)(ldsl + SA(b, h) + aoff + m * 2048 + k * 1024)
#define LDB(dst, b, h) _Pragma("unroll") for (int n = 0; n < 2; ++n) _Pragma("unroll") for (int k = 0; k < 2; ++k) \
    dst[n][k] = *(const LAS bf16x8*)(ldsl + SB(b, h) + boff + n * 2048 + k * 1024)
#define MMA(ai, bj, At, Bx) do { __builtin_amdgcn_s_setprio(1); \
    _Pragma("unroll") for (int m = 0; m < 4; ++m) _Pragma("unroll") for (int n = 0; n < 2; ++n) _Pragma("unroll") for (int k = 0; k < 2; ++k) \
      acc[ai][bj][m][n] = __builtin_amdgcn_mfma_f32_16x16x32_bf16(At[m][k], Bx[n][k], acc[ai][bj][m][n], 0, 0, 0); \
    __builtin_amdgcn_s_setprio(0); } while (0)
#define WAIT_V(n) asm volatile("s_waitcnt vmcnt(" #n ")" ::: "memory")
#define WAIT_L(n) asm volatile("s_waitcnt lgkmcnt(" #n ")" ::: "memory")
#define BAR __builtin_amdgcn_s_barrier()
#define SCHED __builtin_amdgcn_sched_barrier(0)
    const int nMe = skip_ctx ? 64 : 68, nN = N / BM, ntiles = nMe * nN, nextra = nsplit * 4 * nN;
    for (int tile = blockIdx.x; tile < ntiles + nextra; tile += gridDim.x) {
        int pme, pn, kbeg = 0, nt = K / BK, pslot = -1;
        if (tile >= ntiles) {
            const int e = tile - ntiles, ct = e / nsplit, sidx = e - ct * nsplit;
            pme = (ct / nN) * 17; pn = ct % nN; nt = K / BK / nsplit; kbeg = sidx * nt * BK; pslot = e;
        } else {
            int wgid = tile; const int q = ntiles / 8, rr = ntiles % 8, xcd = wgid % 8, off = wgid / 8;
            wgid = (xcd < rr ? xcd * (q + 1) : rr * (q + 1) + (xcd - rr) * q) + off;
            const int nig = 8 * nN, gid = wgid / nig, fm = gid * 8, gsz = (nMe - fm) < 8 ? (nMe - fm) : 8;
            pme = fm + ((wgid % nig) % gsz); pn = (wgid % nig) / gsz;
        }
        const int pm = (skip_ctx && pslot < 0) ? (pme + pme / 16 + 1) : pme;
        const int brow = pm * BM, bcol = pn * BM;
        f32x4 acc[2][2][4][2];
#pragma unroll
        for (int a = 0; a < 2; ++a)
#pragma unroll
            for (int b = 0; b < 2; ++b)
#pragma unroll
                for (int m = 0; m < 4; ++m)
#pragma unroll
                    for (int n = 0; n < 2; ++n) acc[a][b][m][n] = (f32x4){0.f, 0.f, 0.f, 0.f};
        bf16x8 At[4][2], B0[2][2], B1[2][2];
        STAGE(SB(0, 0), Bt, bcol, 0); STAGE(SA(0, 0), A, brow, 0);
        STAGE(SB(0, 1), Bt, bcol + HALF, 0); STAGE(SA(0, 1), A, brow + HALF, 0);
        if (wr == 1) BAR;
        WAIT_V(4); BAR;
        STAGE(SB(1, 0), Bt, bcol, 1); STAGE(SA(1, 0), A, brow, 1); STAGE(SB(1, 1), Bt, bcol + HALF, 1);
        WAIT_V(6); BAR;
        for (int t = 0; t < nt - 2; t += 2) {
            LDB(B0, 0, 0); SCHED; LDA(At, 0, 0); STAGE(SA(1, 1), A, brow + HALF, t + 1);
            WAIT_L(8); BAR; WAIT_L(0); MMA(0, 0, At, B0); BAR; SCHED;
            LDB(B1, 0, 1); STAGE(SB(0, 0), Bt, bcol, t + 2);
            BAR; WAIT_L(0); MMA(0, 1, At, B1); BAR;
            LDA(At, 0, 1); STAGE(SA(0, 0), A, brow, t + 2);
            BAR; WAIT_L(0); MMA(1, 0, At, B0); BAR; SCHED;
            STAGE(SB(0, 1), Bt, bcol + HALF, t + 2);
            WAIT_V(6); BAR; MMA(1, 1, At, B1); BAR;
            LDB(B0, 1, 0); SCHED; LDA(At, 1, 0); STAGE(SA(0, 1), A, brow + HALF, t + 2);
            WAIT_L(8); BAR; WAIT_L(0); MMA(0, 0, At, B0); BAR; SCHED;
            LDB(B1, 1, 1); STAGE(SB(1, 0), Bt, bcol, t + 3);
            BAR; WAIT_L(0); MMA(0, 1, At, B1); BAR;
            LDA(At, 1, 1); STAGE(SA(1, 0), A, brow, t + 3);
            BAR; WAIT_L(0); MMA(1, 0, At, B0); BAR; SCHED;
            STAGE(SB(1, 1), Bt, bcol + HALF, t + 3);
            WAIT_V(6); BAR; MMA(1, 1, At, B1); BAR;
        }
        { LDB(B0, 0, 0); LDA(At, 0, 0); STAGE(SA(1, 1), A, brow + HALF, nt - 1);
          BAR; WAIT_L(0); MMA(0, 0, At, B0); BAR;
          LDB(B1, 0, 1); BAR; WAIT_L(0); MMA(0, 1, At, B1); BAR;
          LDA(At, 0, 1); WAIT_V(4); BAR; WAIT_L(0); MMA(1, 0, At, B0); MMA(1, 1, At, B1); BAR; }
        { LDB(B0, 1, 0); LDA(At, 1, 0); WAIT_V(2); BAR; WAIT_L(0); MMA(0, 0, At, B0); BAR;
          LDB(B1, 1, 1); WAIT_V(0); BAR; WAIT_L(0); MMA(0, 1, At, B1); BAR;
          LDA(At, 1, 1); BAR; WAIT_L(0); MMA(1, 0, At, B0); MMA(1, 1, At, B1); BAR; }
        if (wr == 0) BAR;
        __syncthreads();
        LAS float* st = (LAS float*)ldsl;
        const int etid = otid(), elane = etid & 63, ewid = __builtin_amdgcn_readfirstlane(etid >> 6);
#pragma unroll
        for (int ai = 0; ai < 2; ++ai) {
            if (ai) __syncthreads();
#pragma unroll
            for (int bj = 0; bj < 2; ++bj)
#pragma unroll
                for (int m = 0; m < 4; ++m)
#pragma unroll
                    for (int n = 0; n < 2; ++n)
#pragma unroll
                        for (int j = 0; j < 4; ++j) st[(wr * 64 + m * 16 + fq * 4 + j) * SPITCH + bj * 128 + wc * 32 + n * 16 + fr] = acc[ai][bj][m][n][j];
            __syncthreads();
            const int Rtile = brow + ai * 128;
            if (EPI == EPI_INPROJ) {
                inproj_pass(ea, st, ewid & 3, (bcol >> 6) + (ewid & 3), ewid >> 2, elane, Rtile);
            } else {
                const int b = pm / 17, tt = pm % 17;
                const float* gate = ea.gate + ((tt == 0) ? 4 : b) * 6144 + bcol;
                const float* rin; float* rout; size_t o0;
                if (tt == 0) { o0 = ((size_t)b * CTX + ai * 128) * D; rin = ea.ctx_in; rout = ea.ctx_out; }
                else { o0 = ((size_t)b * SEQ + (size_t)(tt - 1) * 256 + ai * 128) * D; rin = ea.lat_in; rout = ea.lat_out; }
#pragma unroll 4
                for (int i = 0; i < 16; ++i) {
                    const int f = etid + i * 512, row = f >> 6, c4 = f & 63;
                    const f32x4 q = *(const LAS f32x4*)(st + row * SPITCH + c4 * 4);
                    if (EPI == EPI_RESID && pslot >= 0) {
                        const int ct = pslot / nsplit, sidx = pslot - ct * nsplit;
                        *(f32x4*)((sidx < 4 ? slab : slab2) + ((size_t)(((sidx & 3) * 16 + ct) * 256 + ai * 128 + row)) * 256 + c4 * 4) = q;
                    } else if (EPI == EPI_RESID) {
                        const size_t o = o0 + (size_t)row * D + bcol + c4 * 4;
                        const f32x4 gv = *(const f32x4*)(gate + c4 * 4);
                        const f32x4 xi = *(const f32x4*)(rin + o);
                        f32x4 y; y[0] = xi[0] + gv[0] * q[0]; y[1] = xi[1] + gv[1] * q[1]; y[2] = xi[2] + gv[2] * q[2]; y[3] = xi[3] + gv[3] * q[3];
                        *(f32x4*)(rout + o) = y;
                    } else {
                        const float x0 = fmaxf(q[0], 0.f), x1 = fmaxf(q[1], 0.f), x2 = fmaxf(q[2], 0.f), x3 = fmaxf(q[3], 0.f);
                        u32x2 w = {pk2(x0 * x0, x1 * x1), pk2(x2 * x2, x3 * x3)};
                        *(u32x2*)(ea.out + (size_t)(Rtile + row) * ea.ldo + bcol + c4 * 4) = w;
                    }
                }
            }
        }
        if (EPI == EPI_INPROJ && ea.kvcnt != nullptr && (pn == 6 || pn == 7)) {
            asm volatile("s_waitcnt vmcnt(0)" ::: "memory");
            __syncthreads();
            if (etid == 0) __hip_atomic_fetch_add(ea.kvcnt, 1u, __ATOMIC_RELAXED, __HIP_MEMORY_SCOPE_AGENT);
        }
        __syncthreads();
    }
#undef SA
#undef SB
#undef STAGE
#undef LDA
#undef LDB
#undef MMA
#undef WAIT_V
#undef WAIT_L
#undef BAR
#undef SCHED
}

struct A64 { f32x16 o0, o1; float l; };
template <int KSD = 16>
DI void qk64(const bf16_t* kp, const bf16x8 (&qf)[4], f32x16& s) {
    s = zero16();
#pragma unroll
    for (int ks = 0; ks < 4; ++ks) s = mfma(ldg8(kp + ks * KSD), qf[ks], s);
}
template <int SL = 16, int DBO = 32 * T>
DI void pv64(const bf16_t* vp, bf16x8 p0, bf16x8 p1, f32x16& o0, f32x16& o1) {
    o0 = mfma(ldg8(vp), p0, o0);
    o0 = mfma(ldg8(vp + SL), p1, o0);
    o1 = mfma(ldg8(vp + DBO), p0, o1);
    o1 = mfma(ldg8(vp + DBO + SL), p1, o1);
}
DI int k8off(int tk, int r, int h) { const int key = keyperm(r); return ((tk >> 3) + (key >> 3)) * 512 + h * 64 + (key & 7) * 8; }
DI int v8off(int tk, int r, int h) { return ((tk >> 3) + h) * 512 + r * 8; }
DI void pack_p(const f32x16& s, bf16x8& p0, bf16x8& p1) {
    p0 = pack8(s[0], s[1], s[2], s[3], s[4], s[5], s[6], s[7]);
    p1 = pack8(s[8], s[9], s[10], s[11], s[12], s[13], s[14], s[15]);
}
DI void tile_plain(const bf16_t* kp, const bf16_t* vp, const bf16x8 (&qf)[4], float shift, A64& a) {
    f32x16 s; qk64<128>(kp, qf, s);
#pragma unroll
    for (int i = 0; i < 16; ++i) { const float p = ex2(s[i] - shift); a.l += p; s[i] = p; }
    bf16x8 p0, p1; pack_p(s, p0, p1); pv64<1024, 256>(vp, p0, p1, a.o0, a.o1);
}
DI void store_o64(bf16_t* dst, const f32x16& o0, const f32x16& o1, float mul) {
#pragma unroll
    for (int q4 = 0; q4 < 4; ++q4) {
        u32x2 a = {pk2(o0[4 * q4] * mul, o0[4 * q4 + 1] * mul), pk2(o0[4 * q4 + 2] * mul, o0[4 * q4 + 3] * mul)};
        u32x2 b = {pk2(o1[4 * q4] * mul, o1[4 * q4 + 1] * mul), pk2(o1[4 * q4 + 2] * mul, o1[4 * q4 + 3] * mul)};
        *(u32x2*)(dst + 8 * q4) = a; *(u32x2*)(dst + 32 + 8 * q4) = b;
    }
}

template <class TK, class SOFT>
DI void attn64_run(const bf16_t* kbase, const bf16_t* vbase, const bf16x8 (&qf)[4], int n, int r, int h, TK tk_of, SOFT soft, f32x16& o0, f32x16& o1, float& lsum) {
    bf16x8 ka[4], va[4], kb[4], vb[4];
#define A64_LOAD(KK, VV, i_) do { const int _t = tk_of(((i_) < n) ? (i_) : n - 1); const bf16_t* _kp = kbase + k8off(_t, r, h); const bf16_t* _vp = vbase + v8off(_t, r, h); \
        _Pragma("unroll") for (int ks = 0; ks < 4; ++ks) KK[ks] = ldg8(_kp + ks * 128); \
        VV[0] = ldg8(_vp); VV[1] = ldg8(_vp + 1024); VV[2] = ldg8(_vp + 256); VV[3] = ldg8(_vp + 1280); } while (0)
#define A64_STEP(KK, VV, KZ, VZ, i_) do { \
        A64_LOAD(KZ, VZ, (i_) + 1); \
        __builtin_amdgcn_sched_barrier(0); \
        f32x16 s_ = zero16(); \
        _Pragma("unroll") for (int ks = 0; ks < 4; ++ks) s_ = mfma(KK[ks], qf[ks], s_); \
        lsum += soft((i_), s_); \
        bf16x8 p0_, p1_; pack_p(s_, p0_, p1_); \
        o0 = mfma(VV[0], p0_, o0); o1 = mfma(VV[2], p0_, o1); o0 = mfma(VV[1], p1_, o0); o1 = mfma(VV[3], p1_, o1); \
        __builtin_amdgcn_sched_barrier(0); } while (0)
    A64_LOAD(ka, va, 0);
#pragma unroll 1
    for (int i = 0; i < n; i += 2) {
        A64_STEP(ka, va, kb, vb, i);
        if (i + 1 < n) A64_STEP(kb, vb, ka, va, i + 1);
    }
#undef A64_LOAD
#undef A64_STEP
}

struct MixArgs { const LAS float* rpb_l; const LAS float* gains_l;     const bf16_t* qkv; const bf16_t* vt; const bf16_t* kfb; const bf16_t* kg8; bf16_t* mix; const float* cst; const float* rpb; const float* subln; const float* gn; const bf16_t* sin; };

__device__ void attnA_item(const MixArgs& ma, int it, bool ctxq) {
    const int lane = otid() & 63, r = lane & 31, h = lane >> 5;
    int b, head, qb;
    if (!ctxq) { b = it >> 9; head = (it >> 7) & 3; qb = it & 127; } else { b = it >> 5; head = (it >> 3) & 3; qb = it & 7; }
    const int g = head >> 1;
    const int q0 = qb * 32;
    const int Rq = b * T + (ctxq ? 0 : CTX) + q0 + r;
    const float shift = ma.cst[2];
    bf16x8 qf[4];
#pragma unroll
    for (int ks = 0; ks < 4; ++ks) qf[ks] = ldg8(ma.qkv + (size_t)Rq * NIN + head * 64 + ks * 16 + h * 8);
    const bf16_t* kbase = ma.kg8 + (size_t)(b * 6 + g) * 64 * T;
    const bf16_t* vbase = ma.vt + (size_t)(b * NGRP + g) * 64 * T;
    A64 a; a.o0 = zero16(); a.o1 = zero16(); a.l = 0.f;
    {
        const int kt_lo = ctxq ? 0 : max(-4, -(q0 >> 5)), kt_hi = ctxq ? -1 : min(4, (SEQ - 32 - q0) >> 5), nwin = kt_hi - kt_lo + 1;
        auto tk_of = [&](int i) { return (i < nwin) ? (CTX + q0 + (kt_lo + i) * 32) : (i - nwin) * 32; };
        auto soft = [&](int i, f32x16& sc) {
            const int kt = (i < nwin) ? kt_lo + i : 0;
            float sum = 0.f;
#pragma unroll
            for (int e = 0; e < 16; ++e) {
                const int kk = kidx(e, h);
                const bool valid = (kt == -4) ? (kk >= r) : (kt == 4) ? (kk <= r) : true;
                const float pp = valid ? ex2(sc[e] - shift) : 0.f; sum += pp; sc[e] = pp;
            }
            return sum;
        };
        attn64_run(kbase, vbase, qf, nwin + 8, r, h, tk_of, soft, a.o0, a.o1, a.l);
    }
    float l = a.l + __shfl_xor(a.l, 32);
    l += ex2(ma.cst[16 + head] - shift);
    store_o64(ma.mix + (size_t)Rq * D + head * 64 + 4 * h, a.o0, a.o1, 1.f / l);
}

__device__ void attnD_item(const MixArgs& ma, int it, bool ctxq) {
    const int lane = otid() & 63, r = lane & 31, h = lane >> 5;
    const float shift = ma.cst[4];
    int b, head, Rq, rp = 0, j = 0, qr = 0, qc = 0;
    if (!ctxq) {
        b = it >> 9; head = (it >> 7) & 3; const int rem = it & 127; rp = rem >> 2; j = rem & 3;
        qr = 2 * rp + (r >> 4); qc = 16 * j + (r & 15);
        Rq = b * T + CTX + qr * 64 + qc;
    } else { b = it >> 5; head = (it >> 3) & 3; Rq = b * T + (it & 7) * 32 + r; }
    bf16x8 qf[4];
#pragma unroll
    for (int ks = 0; ks < 4; ++ks) qf[ks] = ldg8(ma.qkv + (size_t)Rq * NIN + 2304 + head * 64 + ks * 16 + h * 8);
    const bf16_t* kbase = ma.kg8 + (size_t)(b * 6 + 2 + head) * 64 * T;
    const bf16_t* vbase = ma.vt + (size_t)(b * NGRP + 10 + head) * 64 * T;
    A64 a; a.o0 = zero16(); a.o1 = zero16(); a.l = 0.f;
    {
        const int rs = min(max(qr - 4, 0), 56), cs = min(max(qc - 8, 0), 48);
        const int c0 = min(max(16 * j - 8, 0), 32);
        const int kr_lo = min(max(2 * rp - 4, 0), 56), kr_hi = min(max(2 * rp + 1 - 4, 0), 56) + 7;
        const int nwin = ctxq ? 0 : (kr_hi - kr_lo + 1);
        const LAS float* rpb = ma.rpb_l + head * 465;
        auto tk_of = [&](int i) { return (i < nwin) ? (CTX + (kr_lo + i) * 64 + c0) : (i - nwin) * 32; };
        auto soft = [&](int i, f32x16& sc) {
            float sum = 0.f;
            if (i < nwin) {
                const int kr = kr_lo + i;
                const bool rowok = (kr >= rs) && (kr < rs + 8);
#pragma unroll
                for (int e = 0; e < 16; ++e) {
                    const int kc = c0 + kidx(e, h);
                    const bool valid = rowok && (kc >= cs) && (kc < cs + 16);
                    float pp = 0.f;
                    if (valid) { const float bias = rpb[(kr - qr + 7) * 31 + (kc - qc + 15)]; pp = ex2(sc[e] + bias * LOG2E - shift); }
                    sum += pp; sc[e] = pp;
                }
            } else {
#pragma unroll
                for (int e = 0; e < 16; ++e) { const float pp = ex2(sc[e] - shift); sum += pp; sc[e] = pp; }
            }
            return sum;
        };
        attn64_run(kbase, vbase, qf, nwin + 8, r, h, tk_of, soft, a.o0, a.o1, a.l);
    }
    const float l = a.l + __shfl_xor(a.l, 32);
    store_o64(ma.mix + (size_t)Rq * D + 768 + head * 64 + 4 * h, a.o0, a.o1, 1.f / l);
}

template <bool SHIFT, bool COOP>
__device__ void attnB_item(const MixArgs& ma, int it, bool ctxq, LAS unsigned char* ring = nullptr) {
    const int tidb = otid(), lane = tidb & 63, r = lane & 31, h = lane >> 5;
    int b, head, qb;
    if (!ctxq) { b = it >> 9; head = (it >> 7) & 3; qb = it & 127; } else { b = it >> 5; head = (it >> 3) & 3; qb = it & 7; }
    const int Rq = b * T + (ctxq ? 0 : CTX) + qb * 32 + r;
    const float shift = ma.cst[3];
    bf16x8 q1[2], q2[2];
#pragma unroll
    for (int ks = 0; ks < 2; ++ks) {
        q1[ks] = ldg8(ma.qkv + (size_t)Rq * NIN + 512 + head * 64 + ks * 16 + h * 8);
        q2[ks] = ldg8(ma.qkv + (size_t)Rq * NIN + 512 + head * 64 + 32 + ks * 16 + h * 8);
    }
    const bf16_t* kp = ma.kfb + (size_t)((b * 4 + head) * 136) * 2048 + lane * 8;
    const bf16_t* vp = ma.vt + (size_t)(b * NGRP + 2 + head) * 64 * T + lane * 8;
    f32x16 o1a = zero16(), o1b = zero16(), o2a = zero16(), o2b = zero16();
    float l1 = 0.f, l2 = 0.f;
    const int ntile = ctxq ? 8 : (T / 32);
    const f32x16 sinit = zero16();
#define B_LOADK(KK, kt) do { const bf16_t* _k = kp + (kt) * 2048; KK[0] = ldg8(_k); KK[1] = ldg8(_k + 512); KK[2] = ldg8(_k + 1024); KK[3] = ldg8(_k + 1536); } while (0)
#define B_LOADV(VV, kt) do { const bf16_t* _v = vp + (kt) * 2048; VV[0] = ldg8(_v); VV[1] = ldg8(_v + 512); VV[2] = ldg8(_v + 1024); VV[3] = ldg8(_v + 1536); } while (0)
#define B_QK(KK, S1, S2) do { S1 = mfma(KK[0], q1[0], sinit); S1 = mfma(KK[1], q1[1], S1); S2 = mfma(KK[2], q2[0], sinit); S2 = mfma(KK[3], q2[1], S2); } while (0)
#define B_EXP8(S, o, P, L) do { \
        const float e0 = ex2(SHIFT ? S[o] - shift : S[o]), e1 = ex2(SHIFT ? S[o + 1] - shift : S[o + 1]), e2 = ex2(SHIFT ? S[o + 2] - shift : S[o + 2]), e3 = ex2(SHIFT ? S[o + 3] - shift : S[o + 3]); \
        const float e4 = ex2(SHIFT ? S[o + 4] - shift : S[o + 4]), e5 = ex2(SHIFT ? S[o + 5] - shift : S[o + 5]), e6 = ex2(SHIFT ? S[o + 6] - shift : S[o + 6]), e7 = ex2(SHIFT ? S[o + 7] - shift : S[o + 7]); \
        L += ((e0 + e1) + (e2 + e3)) + ((e4 + e5) + (e6 + e7)); P = pack8(e0, e1, e2, e3, e4, e5, e6, e7); } while (0)
#define B_SOFTPV(S1, S2, VV) do { \
        bf16x8 pa0, pa1, pb0, pb1; \
        B_EXP8(S1, 0, pa0, l1); B_EXP8(S1, 8, pa1, l1); B_EXP8(S2, 0, pb0, l2); B_EXP8(S2, 8, pb1, l2); \
        __builtin_amdgcn_sched_barrier(0); \
        o1a = mfma(VV[0], pa0, o1a); o1a = mfma(VV[1], pa1, o1a); o1b = mfma(VV[2], pa0, o1b); o1b = mfma(VV[3], pa1, o1b); \
        o2a = mfma(VV[0], pb0, o2a); o2a = mfma(VV[1], pb1, o2a); o2b = mfma(VV[2], pb0, o2b); o2b = mfma(VV[3], pb1, o2b); \
        } while (0)
    bf16x8 ones;
#pragma unroll
    for (int i = 0; i < 8; ++i) ones[i] = (short)0x3F80;
    f32x16 la = zero16(), lb = zero16();
    bf16x8 kf[4], vf[4];
    f32x16 s1, s2;
    if (COOP) {
        const bf16_t* gsrc = (tidb < 256) ? (ma.kfb + (size_t)((b * 4 + head) * 136) * 2048 + tidb * 8) : (ma.vt + (size_t)(b * NGRP + 2 + head) * 64 * T + (tidb - 256) * 8);
        LAS unsigned char* wdst = ring + tidb * 16;
        const LAS unsigned char* rsrc = ring + lane * 16;
        u32x4 rg = *(const u32x4*)gsrc;
        *(LAS u32x4*)wdst = rg;
        rg = *(const u32x4*)(gsrc + 2048);
        *(LAS u32x4*)(wdst + 8192) = rg;
        int st = 0, st2 = 2;
#pragma unroll 1
        for (int kt = 0; kt < ntile; ++kt) {
            if (kt + 2 < ntile) rg = *(const u32x4*)(gsrc + (size_t)(kt + 2) * 2048);
            __syncthreads();
            const LAS unsigned char* sp = rsrc + st * 8192;
#pragma unroll
            for (int f = 0; f < 4; ++f) { kf[f] = *(const LAS bf16x8*)(sp + f * 1024); vf[f] = *(const LAS bf16x8*)(sp + 4096 + f * 1024); }
            B_QK(kf, s1, s2);
            __builtin_amdgcn_sched_barrier(0);
            B_SOFTPV(s1, s2, vf);
            if (kt + 2 < ntile) *(LAS u32x4*)(wdst + st2 * 8192) = rg;
            st = (st == 2) ? 0 : st + 1; st2 = (st2 == 2) ? 0 : st2 + 1;
        }
        __syncthreads();
    } else {
    B_LOADK(kf, 0); B_LOADV(vf, 0);
#pragma unroll 1
    for (int kt = 0; kt < ntile; ++kt) {
        const int k1 = (kt + 1 < ntile) ? kt + 1 : ntile - 1;
        B_QK(kf, s1, s2);
        B_LOADK(kf, k1);
        __builtin_amdgcn_sched_barrier(0);
        B_SOFTPV(s1, s2, vf);
        B_LOADV(vf, k1);
        __builtin_amdgcn_sched_barrier(0);
    }
    }
    l1 += __shfl_xor(l1, 32); l2 += __shfl_xor(l2, 32);
#undef B_LOADK
#undef B_LOADV
#undef B_QK
#undef B_SOFTPV
#undef B_EXP8
    const float i1 = 1.f / l1, i2 = ma.cst[0] / l2;
    float ss = 0.f;
#pragma unroll
    for (int i = 0; i < 16; ++i) { o1a[i] = o1a[i] * i1 - o2a[i] * i2; o1b[i] = o1b[i] * i1 - o2b[i] * i2; ss += o1a[i] * o1a[i] + o1b[i] * o1b[i]; }
    ss += __shfl_xor(ss, 32);
    const float mul = rsqrtf(ss * (1.f / 64.f) + EPS) * ma.cst[1];
#pragma unroll
    for (int i = 0; i < 16; ++i) { const int d = crow(i, h); o1a[i] *= ma.gains_l[d]; o1b[i] *= ma.gains_l[32 + d]; }
    store_o64(ma.mix + (size_t)Rq * D + 256 + head * 64 + 4 * h, o1a, o1b, mul);
}

__device__ void retKV_item(const MixArgs& ma, int it, float* kvout) {
    const int lane = otid() & 63, r = lane & 31, h = lane >> 5;
    const int dir = it & 1, c = (it >> 1) % 34, bh = (it >> 1) / 34, b = bh >> 2, head = bh & 3;
    const float lg = dir ? ma.cst[12 + head] : ma.cst[8 + head];
    const bf16_t* vp = ma.vt + (size_t)(b * NGRP + 6 + head) * 64 * T + v8off(c * 128, r, h);
    const bf16_t* kp = ma.vt + (size_t)(b * NGRP + 14 + head) * 64 * T + v8off(c * 128, r, h);
    f32x16 acc[2][2];
    acc[0][0] = zero16(); acc[0][1] = zero16(); acc[1][0] = zero16(); acc[1][1] = zero16();
#pragma unroll
    for (int ks = 0; ks < 8; ++ks) {
        const bf16x8 v0 = ldg8(vp + ks * 1024), v1 = ldg8(vp + 256 + ks * 1024);
        bf16x8 k0 = ldg8(kp + ks * 1024), k1 = ldg8(kp + 256 + ks * 1024);
        float w[8];
#pragma unroll
        for (int j = 0; j < 8; ++j) { const int tl = ks * 16 + h * 8 + j; w[j] = ex2(lg * (float)(dir ? tl : (127 - tl))); }
        float f0[8], f1[8];
#pragma unroll
        for (int j = 0; j < 8; ++j) { f0[j] = bf2f((unsigned short)k0[j]) * w[j]; f1[j] = bf2f((unsigned short)k1[j]) * w[j]; }
        k0 = pack8(f0[0], f0[1], f0[2], f0[3], f0[4], f0[5], f0[6], f0[7]);
        k1 = pack8(f1[0], f1[1], f1[2], f1[3], f1[4], f1[5], f1[6], f1[7]);
        acc[0][0] = mfma(v0, k0, acc[0][0]); acc[0][1] = mfma(v0, k1, acc[0][1]);
        acc[1][0] = mfma(v1, k0, acc[1][0]); acc[1][1] = mfma(v1, k1, acc[1][1]);
    }
    float* dst = kvout + ((size_t)((bh * 2 + dir) * 34 + c)) * 4096;
#pragma unroll
    for (int db = 0; db < 2; ++db)
#pragma unroll
        for (int nb = 0; nb < 2; ++nb)
#pragma unroll
            for (int i = 0; i < 16; ++i) dst[(db * 32 + crow(i, h)) * 64 + nb * 32 + r] = acc[db][nb][i];
}

__device__ void ret_scan(const float* __restrict__ cst, const float* __restrict__ kv, bf16_t* __restrict__ sin) {
    const int n = NB * 4 * 2 * 4096;
    for (int e = blockIdx.x * 512 + otid(); e < n; e += gridDim.x * 512) {
        const int el = e & 4095, bhd = e >> 12, dir = bhd & 1, head = (bhd >> 1) & 3;
        const float lg = dir ? cst[12 + head] : cst[8 + head];
        const float dec = ex2(lg * 128.f);
        const size_t base = (size_t)bhd * 34 * 4096 + el;
        float v[34];
#pragma unroll
        for (int p = 0; p < 34; ++p) v[p] = kv[base + (size_t)p * 4096];
        float S = 0.f;
        if (dir == 0) {
#pragma unroll
            for (int p = 0; p < 34; ++p) { sin[base + (size_t)p * 4096] = (bf16_t)(pk2(S, 0.f) & 0xffffu); S = S * dec + v[p]; }
        } else {
            sin[base + 4096] = (bf16_t)(pk2(S, 0.f) & 0xffffu); S = S * dec + v[1];
            sin[base] = (bf16_t)(pk2(S, 0.f) & 0xffffu); S = S * dec + v[0];
#pragma unroll
            for (int c = 33; c >= 2; --c) { sin[base + (size_t)c * 4096] = (bf16_t)(pk2(S, 0.f) & 0xffffu); S = S * dec + v[c]; }
        }
    }
}

__device__ void retOut_item(const MixArgs& ma, int it) {
    const int lane = otid() & 63, r = lane & 31, h = lane >> 5;
    const int qs = it & 3, c = (it >> 2) % 34, bh = (it >> 2) / 34, b = bh >> 2, head = bh & 3;
    const float lgf = ma.cst[8 + head], lgb = ma.cst[12 + head];
    const int R0 = b * T + c * 128, Rq = R0 + qs * 32 + r, iq = qs * 32 + r;
    bf16x8 qf[4];
#pragma unroll
    for (int ks = 0; ks < 4; ++ks) qf[ks] = ldg8(ma.qkv + (size_t)Rq * NIN + 1280 + head * 64 + ks * 16 + h * 8);
    const bf16_t* kbase = ma.qkv + 1536 + head * 64 + h * 8;
    const bf16_t* vbase = ma.vt + (size_t)(b * NGRP + 6 + head) * 64 * T + v8off(c * 128, r, h);
    f32x16 o0 = zero16(), o1 = zero16();
    {
        bf16x8 kc[4], vc[4], kn[4], vn[4];
        const bf16_t* kp0 = kbase + (size_t)(R0 + keyperm(r)) * NIN;
#pragma unroll
        for (int ks = 0; ks < 4; ++ks) kc[ks] = ldg8(kp0 + ks * 16);
        vc[0] = ldg8(vbase); vc[1] = ldg8(vbase + 1024); vc[2] = ldg8(vbase + 256); vc[3] = ldg8(vbase + 1280);
#pragma unroll 1
        for (int kb = 0; kb < 4; ++kb) {
            {
                const int kn_i = (kb < 3) ? kb + 1 : kb;
                const bf16_t* kp = kp0 + (size_t)(kn_i * 32) * NIN; const bf16_t* vp = vbase + kn_i * 2048;
#pragma unroll
                for (int ks = 0; ks < 4; ++ks) kn[ks] = ldg8(kp + ks * 16);
                vn[0] = ldg8(vp); vn[1] = ldg8(vp + 1024); vn[2] = ldg8(vp + 256); vn[3] = ldg8(vp + 1280);
            }
            __builtin_amdgcn_sched_barrier(0);
            f32x16 s = zero16();
#pragma unroll
            for (int ks = 0; ks < 4; ++ks) s = mfma(kc[ks], qf[ks], s);
#pragma unroll
            for (int i = 0; i < 16; ++i) {
                const int jk = kb * 32 + kidx(i, h);
                const int dlt = iq - jk;
                const float w = (dlt > 0) ? ex2(lgf * (float)dlt) : (dlt < 0) ? ex2(lgb * (float)(-dlt)) : 2.f;
                s[i] *= w;
            }
            bf16x8 p0, p1; pack_p(s, p0, p1);
            o0 = mfma(vc[0], p0, o0); o1 = mfma(vc[2], p0, o1); o0 = mfma(vc[1], p1, o0); o1 = mfma(vc[3], p1, o1);
            __builtin_amdgcn_sched_barrier(0);
#pragma unroll
            for (int ks = 0; ks < 4; ++ks) { kc[ks] = kn[ks]; vc[ks] = vn[ks]; }
        }
    }
#pragma unroll
    for (int dir = 0; dir < 2; ++dir) {
        const bf16_t* sp = ma.sin + ((size_t)((bh * 2 + dir) * 34 + c)) * 4096 + r * 64 + h * 8;
        f32x16 x0 = zero16(), x1 = zero16();
#pragma unroll
        for (int ks = 0; ks < 4; ++ks) { x0 = mfma(ldg8(sp + ks * 16), qf[ks], x0); x1 = mfma(ldg8(sp + 32 * 64 + ks * 16), qf[ks], x1); }
        const float w = dir ? ex2(lgb * (float)(128 - iq)) : ex2(lgf * (float)(iq + 1));
#pragma unroll
        for (int i = 0; i < 16; ++i) { o0[i] += w * x0[i]; o1[i] += w * x1[i]; }
    }
    float ss = 0.f;
#pragma unroll
    for (int i = 0; i < 16; ++i) ss += o0[i] * o0[i] + o1[i] * o1[i];
    ss += __shfl_xor(ss, 32);
    const float mul = rsqrtf(ss * (1.f / 64.f) + EPS);
    const bf16_t* gp = ma.qkv + (size_t)Rq * NIN + 2048 + head * 64 + 4 * h;
#pragma unroll
    for (int q4 = 0; q4 < 4; ++q4) {
        const u32x2 ga = *(const u32x2*)(gp + 8 * q4), gb = *(const u32x2*)(gp + 32 + 8 * q4);
#pragma unroll
        for (int e = 0; e < 4; ++e) {
            const int i = 4 * q4 + e, d = crow(i, h);
            const float gta = bf2f((unsigned short)((e & 1) ? (ga[e >> 1] >> 16) : (ga[e >> 1] & 0xffffu)));
            const float gtb = bf2f((unsigned short)((e & 1) ? (gb[e >> 1] >> 16) : (gb[e >> 1] & 0xffffu)));
            o0[i] *= ma.gains_l[64 + d] * gta; o1[i] *= ma.gains_l[96 + d] * gtb;
        }
    }
    store_o64(ma.mix + (size_t)Rq * D + 512 + head * 64 + 4 * h, o0, o1, mul);
}

__global__ void __launch_bounds__(512) fwd_kernel(Params p) {
    extern __shared__ __attribute__((aligned(16))) unsigned char lds[];
    cg::grid_group grid = cg::this_grid();
    volatile LAS unsigned* xbw = (volatile LAS unsigned*)(lds + LDS_MAIN);
    if (threadIdx.x == 0) { xbw[0] = 0u; xbw[1] = 0u; xbw[2] = 0u; xbw[3] = 0u; }
    __syncthreads();
    XcdBarrier xb = xcd_barrier_post((unsigned*)(p.ws + WS_BAR), xbw);

    unsigned char* ws = p.ws;
    float* tab = (float*)(ws + WS_TAB);
    float* modb = (float*)(ws + WS_MOD);
    float* ctxb = (float*)(ws + WS_CTXB);
    bf16_t* act = (bf16_t*)(ws + WS_ACT);
    float* kvb = (float*)(ws + WS_KV);
    bf16_t* sinb = (bf16_t*)(ws + WS_SIN);
    bf16_t* qkv = (bf16_t*)(ws + WS_QKV);
    bf16_t* vt = (bf16_t*)(ws + WS_VT);
    bf16_t* ub = (bf16_t*)(ws + WS_QKV);
    const bf16_t* w_in = (const bf16_t*)(ws + WS_W + W_IN_OFF);
    const bf16_t* w_out = (const bf16_t*)(ws + WS_W + W_OUT_OFF);
    const bf16_t* w_1 = (const bf16_t*)(ws + WS_W + W_1_OFF);
    const bf16_t* w_2 = (const bf16_t*)(ws + WS_W + W_2_OFF);
    const int nw = gridDim.x * 8;
    float* slabb = (float*)(ws + WS_KV);
    constexpr int NSPLIT = 8;
    float* slabb2 = (float*)(ws + WS_QKV + 142606336);
#define GW (blockIdx.x * 8 + (otid() >> 6))

    { int nr0 = (PROBE_DUP == 6) ? 2 : 1; asm volatile("" : "+s"(nr0));
#pragma unroll 1
      for (int rep = 0; rep < nr0; ++rep) {
    if (blockIdx.x == 0) prep_tables(p);
    for (int it = blockIdx.x; it < 192; it += gridDim.x) mod_item(p, it, lds);
    conv_layer(p, 0, lds, 0, 768, 0, gridDim.x);
      } }
    if (p.ws == nullptr) grid.sync();
    if (threadIdx.x == 0) { unsigned nloc, nx; xcd_barrier_complete(xb.bar, xb.x, nloc, nx); xbw[0] = nloc; xbw[1] = nx; }
    __syncthreads();
    xcd_barrier(xb);

#pragma nounroll
    for (int l = 0; l < 2; ++l) {
        const float* modl = modb + l * 5 * 6144;
        const float* cst = tab + 3072 + l * 32;
        const float* lat_in = (l == 0) ? p.in[0] : p.out;
        const float* ctx_in = (l == 0) ? p.in[2] : ctxb;
        if (l == 1 && (1088 % gridDim.x) == 0) conv_layer(p, 1, lds, 0, 768, 0, gridDim.x);
        { int nr = (PROBE_DUP == 4) ? 2 : 1; asm volatile("" : "+s"(nr));
#pragma unroll 1
          for (int rep = 0; rep < nr; ++rep) norm_phase(lat_in, ctx_in, p.in[6] + l * D, modl, 0, 1024, act, false, slabb, (l == 1) ? NSPLIT : 0, modb + 4 * 6144 + 5120, nullptr, slabb2); }
        xcd_barrier(xb);
        if (PROBE_DUP == 7) xcd_barrier(xb);
        MixArgs ma{}; ma.qkv = qkv; ma.vt = vt; ma.kfb = (const bf16_t*)(ws + WS_KFB); ma.kg8 = (const bf16_t*)(ws + WS_KG8); ma.mix = act; ma.cst = cst; ma.rpb = p.in[25] + l * 1860; ma.subln = p.in[19] + l * 64; ma.gn = p.in[22] + l * 64; ma.sin = sinb;
        const int nb4 = 816 % gridDim.x;
        const bool kv_early = nb4 != 0;
        {
            EpiArgs ea{}; ea.out = qkv; ea.ldo = NIN; ea.vt = vt; ea.kfb = (bf16_t*)(ws + WS_KFB); ea.kg8 = (bf16_t*)(ws + WS_KG8); ea.tab = tab;
            ea.aq = p.in[10] + l * 64; ea.ak = p.in[11] + l * 64; ea.bq = p.in[13] + l * 32; ea.bk = p.in[14] + l * 32; ea.dq = p.in[23] + l * 64; ea.dk = p.in[24] + l * 64;
            unsigned* kvcnt = (unsigned*)(ws + WS_BAR) + 3520 + l * 64;
            ea.kvcnt = kv_early ? kvcnt : nullptr;
            { int nr8 = (PROBE_DUP == 8) ? 2 : 1; asm volatile("" : "+s"(nr8));
#pragma unroll 1
              for (int rep = 0; rep < nr8; ++rep) gemm_phase8<EPI_INPROJ>(act, w_in, 1024, NIN, ea, lds, false); }
            conv_layer(p, l, lds, 768, 3072, nb4, gridDim.x - nb4);
            if (kv_early && (int)blockIdx.x >= nb4) {
                if (threadIdx.x == 0) {
                    unsigned sp = 0;
                    while (__hip_atomic_load(kvcnt, __ATOMIC_RELAXED, __HIP_MEMORY_SCOPE_AGENT) < 136u) { __builtin_amdgcn_s_sleep(2); if (++sp > (1u << 22)) { atomicAdd((unsigned*)(ws + WS_BAR) + XB_TMO, 1u); break; } }
                    __builtin_amdgcn_fence(__ATOMIC_ACQUIRE, "agent");
                    asm volatile("s_waitcnt vmcnt(0)" ::: "memory");
                }
                __syncthreads();
                const int nidle = gridDim.x - nb4;
                for (int it = ((int)blockIdx.x - nb4) * 8 + (otid() >> 6); it < NB * 4 * 34 * 2; it += nidle * 8) retKV_item(ma, it, kvb);
            }
        }
        xcd_barrier(xb);
        if (!kv_early) {
            for (int it = GW; it < NB * 4 * 34 * 2; it += nw) retKV_item(ma, it, kvb);
            xcd_barrier(xb);
        }
        { int nr = (PROBE_DUP == 5) ? 2 : 1; asm volatile("" : "+s"(nr));
#pragma unroll 1
          for (int rep = 0; rep < nr; ++rep) ret_scan(cst, kvb, sinb); }
        xcd_barrier(xb);
        if (PROBE_DUP == 7) xcd_barrier(xb);
        {
            LAS float* rl = (LAS float*)(lds + 65536);
            for (int i = otid(); i < 1860; i += 512) rl[i] = ma.rpb[i];
            if (otid() < 128) rl[2048 + otid()] = (otid() < 64) ? ma.subln[otid()] : ma.gn[otid() - 64];
            ma.rpb_l = rl; ma.gains_l = rl + 2048;
            __syncthreads();
        }
        {
            const int wv = otid() >> 6;
            const bool noshift = cst[3] <= 64.f;
            for (int itb = blockIdx.x; itb < 256; itb += gridDim.x) {
                if (wv < 4) {
#pragma unroll 1
                    for (int k = 0; k < 2; ++k) {
                        const int it = itb * 8 + 2 * wv + k;
                        if (noshift) attnB_item<false, false>(ma, it, false); else attnB_item<true, false>(ma, it, false);
                    }
                } else {
                    __builtin_amdgcn_s_setprio(2);
#pragma unroll 1
                    for (int k = 0; k < 2; ++k) {
                        const int it = itb * 8 + 2 * (wv - 4) + k;
                        attnA_item(ma, it, false);
                        attnD_item(ma, it, false);
                        retOut_item(ma, ((it >> 7) * 34 + 2 + ((it & 127) >> 2)) * 4 + (it & 3));
                    }
                    __builtin_amdgcn_s_setprio(0);
                }
            }
            if (l == 0 && wv >= 4) {
                const int pw = blockIdx.x * 4 + (wv - 4), npw = gridDim.x * 4;
                for (int i = pw; i < 128; i += npw) retOut_item(ma, ((i >> 3) * 34 + ((i & 7) >> 2)) * 4 + (i & 3));
                for (int it = (pw + npw - 256 % npw) % npw; it < 128; it += npw) attnB_item<true, false>(ma, it, true);
                for (int it = (pw + npw - 512 % npw) % npw; it < 128; it += npw) attnA_item(ma, it, true);
                for (int it = (pw + npw - 768 % npw) % npw; it < 128; it += npw) attnD_item(ma, it, true);
            }
        }
        xcd_barrier(xb);
        if (PROBE_DUP == 7) xcd_barrier(xb);
        {
            EpiArgs ea{}; ea.lat_in = lat_in; ea.ctx_in = ctx_in; ea.lat_out = p.out; ea.ctx_out = ctxb; ea.gate = modl + 2048;
            gemm_phase8<EPI_RESID>(act, w_out, 1024, 1024, ea, lds, true, (l == 0) ? NSPLIT : 0, slabb, slabb2);
        }
        xcd_barrier(xb);
        if (PROBE_DUP == 7) xcd_barrier(xb);
        { int nr = (PROBE_DUP == 4) ? 2 : 1; asm volatile("" : "+s"(nr));
#pragma unroll 1
          for (int rep = 0; rep < nr; ++rep) norm_phase(p.out, (l == 0) ? ctx_in : ctxb, p.in[7] + l * D, modl, 3072, 4096, act, l == 1, slabb, (l == 0) ? NSPLIT : 0, modl + 4 * 6144 + 2048, ctxb, slabb2); }
        xcd_barrier(xb);
        if (PROBE_DUP == 7) xcd_barrier(xb);
        {
            EpiArgs ea{}; ea.out = ub; ea.ldo = DFF;
            int nrep = (PROBE_DUP == 1) ? 2 : 1; asm volatile("" : "+s"(nrep));
#pragma unroll 1
            for (int rep = 0; rep < nrep; ++rep) gemm_phase8<EPI_RELU2>(act, w_1, 1024, DFF, ea, lds, l == 1);
            if (l == 0 && (1088 % gridDim.x) != 0) { const int nb5 = 1088 % gridDim.x; conv_layer(p, 1, lds, 0, 768, nb5, gridDim.x - nb5); }
        }
        xcd_barrier(xb);
        if (PROBE_DUP == 7) xcd_barrier(xb);
        {
            EpiArgs ea{}; ea.lat_in = p.out; ea.ctx_in = ctxb; ea.lat_out = p.out; ea.ctx_out = ctxb; ea.gate = modl + 5120;
            gemm_phase8<EPI_RESID>(ub, w_2, 4096, 1024, ea, lds, true, (l == 0) ? NSPLIT : 0, slabb, slabb2);
        }
        if (l == 0) xcd_barrier(xb);
    }
}

extern "C" void kernel_launch(void* const* d_in, const int* in_sizes, int n_in, void* d_out, int out_size, void* d_ws, size_t ws_size, hipStream_t stream) {
    static int grid_blocks = 0;
    if (!grid_blocks) {
        int dev = 0, cus = 0, per_cu = 0;
        hipGetDevice(&dev);
        hipDeviceGetAttribute(&cus, hipDeviceAttributeMultiprocessorCount, dev);
        hipFuncSetAttribute((const void*)fwd_kernel, hipFuncAttributeMaxDynamicSharedMemorySize, LDS_BYTES);
        hipOccupancyMaxActiveBlocksPerMultiprocessor(&per_cu, (const void*)fwd_kernel, 512, LDS_BYTES);
        if (per_cu < 1) { fprintf(stderr, "kernel_launch: occupancy query says %d blocks/CU\n", per_cu); per_cu = 1; }
        grid_blocks = cus;
    }
    if (n_in != 28 || ws_size < WS_END) { fprintf(stderr, "kernel_launch: bad args n_in %d ws %zu need %zu\n", n_in, ws_size, (size_t)WS_END); return; }
    hipMemsetAsync((char*)d_ws + WS_BAR, 0, 16384, stream);
    Params p{};
    for (int i = 0; i < 28; ++i) p.in[i] = (const float*)d_in[i];
    p.out = (float*)d_out; p.ws = (unsigned char*)d_ws;
    void* args[] = {&p};
    hipError_t e = hipLaunchCooperativeKernel((const void*)fwd_kernel, dim3(grid_blocks), dim3(512), args, LDS_BYTES, stream);
    if (e != hipSuccess) fprintf(stderr, "cooperative launch failed: %s (grid %d)\n", hipGetErrorString(e), grid_blocks);
}
```

```cpp
#include <hip/hip_runtime.h>
#include <hip/hip_cooperative_groups.h>
#include <cstdio>
#include <cstdint>
namespace cg = cooperative_groups;
#ifndef PROBE_DUP
#define PROBE_DUP 0
#endif

#define DI __device__ __forceinline__
#define LAS __attribute__((address_space(3)))
typedef short bf16x8 __attribute__((ext_vector_type(8)));
typedef float f32x16 __attribute__((ext_vector_type(16)));
typedef float f32x4 __attribute__((ext_vector_type(4)));
typedef float f32x2 __attribute__((ext_vector_type(2)));
typedef unsigned u32x4 __attribute__((ext_vector_type(4)));
typedef unsigned u32x2 __attribute__((ext_vector_type(2)));
typedef __bf16 bf16x2_t __attribute__((ext_vector_type(2)));
typedef unsigned short bf16_t;

constexpr int NB = 4, SEQ = 4096, CTX = 256, T = SEQ + CTX, M = NB * T, D = 1024, DFF = 4096, NIN = 3072, NGRP = 18;
constexpr float EPS = 1e-6f, LOG2E = 1.4426950408889634f;

constexpr size_t WS_BAR = 0;
constexpr size_t WS_TAB = 16384;
constexpr size_t WS_MOD = 65536;
constexpr size_t WS_CTXB = 327680;
constexpr size_t WS_W = WS_CTXB + 4194304;
constexpr size_t W_IN_OFF = 0, W_OUT_OFF = 6291456, W_1_OFF = 8388608, W_2_OFF = 16777216;
constexpr size_t WS_ACT = WS_W + 25165824;
constexpr size_t WS_KV = WS_ACT + 35651584;
constexpr size_t WS_SIN = WS_KV + 17825792;
constexpr size_t WS_QKV = WS_SIN + 8912896;
constexpr size_t WS_VT = WS_QKV + 106954752;
constexpr size_t WS_KFB = WS_VT + 40108032;
constexpr size_t WS_KG8 = WS_KFB + 8912896;
constexpr size_t WS_END = WS_KG8 + 13369344;

constexpr int LDS_PITCH = 80, STAGE_MAT = 256 * LDS_PITCH, LDS_MAIN = 128 * 260 * 4, LDS_BYTES = LDS_MAIN + 256;

struct Params { const float* in[28]; float* out; unsigned char* ws; };

DI unsigned pk2(float a, float b) { f32x2 v = {a, b}; bf16x2_t r = __builtin_convertvector(v, bf16x2_t); return __builtin_bit_cast(unsigned, r); }
DI bf16x8 pack8(float a0, float a1, float a2, float a3, float a4, float a5, float a6, float a7) {
    u32x4 p = {pk2(a0, a1), pk2(a2, a3), pk2(a4, a5), pk2(a6, a7)}; return __builtin_bit_cast(bf16x8, p);
}
DI f32x16 mfma(bf16x8 a, bf16x8 b, f32x16 c) { return __builtin_amdgcn_mfma_f32_32x32x16_bf16(a, b, c, 0, 0, 0); }
DI f32x16 zero16() { f32x16 z; for (int i = 0; i < 16; ++i) z[i] = 0.f; return z; }
DI float ex2(float x) { return __builtin_amdgcn_exp2f(x); }
DI bf16x8 ldg8(const bf16_t* p) { return *(const bf16x8*)p; }
DI int crow(int i, int h) { return (i & 3) + 8 * (i >> 2) + 4 * h; }
DI int keyperm(int r) { const int a = r >> 3, g = (r >> 2) & 1, c = r & 3; return (a >> 1) * 16 + g * 8 + (a & 1) * 4 + c; }
DI int kidx(int i, int h) { return (i >> 3) * 16 + h * 8 + (i & 7); }
DI float bf2f(unsigned short u) { return __uint_as_float(((unsigned)u) << 16); }
DI int otid() { int t = threadIdx.x; asm volatile("" : "+v"(t)); return t; }
DI void stwt16(void* p, bf16x8 v) { asm volatile("global_store_dwordx4 %0, %1, off sc1\n\ts_nop 1" :: "v"(p), "v"(v) : "memory"); }
DI float wave_sum(float v) { for (int o = 32; o > 0; o >>= 1) v += __shfl_xor(v, o); return v; }

#define XB_TMO      128
#define XB_XCNT(j)  (256  + 64 * (j))
#define XB_XSUB(j)  (1280 + 64 * (j))
#define XB_XGEN(j)  (2304 + 64 * (j))
#define XB_TOP      3328
#define XB_TOPGEN   3392
#define XCD_BAR_WORDS 3456
#define XB_SPIN_CAP (1u << 22)
DI unsigned xb_ld(unsigned* p) { return __hip_atomic_load(p, __ATOMIC_RELAXED, __HIP_MEMORY_SCOPE_AGENT); }
DI unsigned xb_add(unsigned* p, unsigned v) { return __hip_atomic_fetch_add(p, v, __ATOMIC_RELAXED, __HIP_MEMORY_SCOPE_AGENT); }
DI unsigned xb_xcc_id() { return (unsigned)__builtin_amdgcn_s_getreg((3 << 11) | 20) & 0xFu; }
#define XB_SPIN(cond, bar) do { unsigned _sp = 0; while (cond) { __builtin_amdgcn_s_sleep(1); \
    if ((++_sp & 255u) == 0u) { if (xb_ld(&(bar)[XB_TMO])) break; if (_sp > XB_SPIN_CAP) { atomicAdd(&(bar)[XB_TMO], 1u); break; } } } } while (0)
struct XcdBarrier { unsigned* bar; unsigned x; volatile LAS unsigned* st; };
DI XcdBarrier xcd_barrier_post(unsigned* bar, volatile LAS unsigned* st) {
    XcdBarrier b; b.bar = bar; b.x = xb_xcc_id(); b.st = st;
    if (threadIdx.x == 0) (void)xb_add(&bar[XB_XCNT(b.x)], 1u);
    return b;
}
DI void xcd_barrier_complete(unsigned* bar, unsigned x, unsigned& nloc, unsigned& nx) {
    const unsigned G = gridDim.x * gridDim.y * gridDim.z;
    unsigned sum, cnt, mine, sp = 0u;
    for (;;) {
        sum = 0u; cnt = 0u; mine = 0u;
#pragma unroll
        for (unsigned j = 0; j < 16; ++j) { const unsigned c = xb_ld(&bar[XB_XCNT(j)]); sum += c; cnt += (c > 0u) ? 1u : 0u; mine = (j == x) ? c : mine; }
        if (sum == G) break;
        __builtin_amdgcn_s_sleep(1);
        if ((++sp & 255u) == 0u) { if (xb_ld(&bar[XB_TMO])) break; if (sp > XB_SPIN_CAP) { atomicAdd(&bar[XB_TMO], 1u); break; } }
    }
    nloc = mine > 0u ? mine : 1u; nx = cnt > 0u ? cnt : 1u;
}
DI void xcd_barrier(const XcdBarrier& b) {
    asm volatile("s_waitcnt vmcnt(0)" ::: "memory");
    __syncthreads();
    if (threadIdx.x == 0) {
        unsigned* bar = b.bar;
        __builtin_amdgcn_s_waitcnt(0);
        unsigned nloc = b.st[0], nx = b.st[1];
        const unsigned old = xb_add(&bar[XB_XSUB(b.x)], 1u);
        const unsigned gen = old / nloc;
        if (old + 1u == (gen + 1u) * nloc) {
            __builtin_amdgcn_fence(__ATOMIC_RELEASE, "agent");
            asm volatile("s_waitcnt vmcnt(0)" ::: "memory");
            const unsigned og = xb_add(&bar[XB_TOP], 1u);
            const unsigned tg = og / nx;
            if (og + 1u == (tg + 1u) * nx) xb_add(&bar[XB_TOPGEN], 1u);
            else XB_SPIN(xb_ld(&bar[XB_TOPGEN]) == tg, bar);
            __builtin_amdgcn_fence(__ATOMIC_ACQUIRE, "agent");
            xb_add(&bar[XB_XGEN(b.x)], 1u);
            asm volatile("s_waitcnt vmcnt(0)" ::: "memory");
        } else {
            __builtin_amdgcn_fence(__ATOMIC_ACQUIRE, "agent");
            asm volatile("s_waitcnt vmcnt(0)" ::: "memory");
            XB_SPIN(xb_ld(&bar[XB_XGEN(b.x)]) == gen, bar);
        }
    }
    __syncthreads();
}

DI void sincos_acc(float xf, float& s, float& c) {
    const double x = (double)xf;
    const double n = rint(x * 0.6366197723675814);
    const double rr = x - n * 1.5707963267948966;
    const double r2 = rr * rr;
    const double sp = rr * (1.0 + r2 * (-1.0 / 6 + r2 * (1.0 / 120 + r2 * (-1.0 / 5040 + r2 * (1.0 / 362880 + r2 * (-1.0 / 39916800 + r2 * (1.0 / 6227020800.0)))))));
    const double cp = 1.0 + r2 * (-0.5 + r2 * (1.0 / 24 + r2 * (-1.0 / 720 + r2 * (1.0 / 40320 + r2 * (-1.0 / 3628800 + r2 * (1.0 / 479001600 + r2 * (-1.0 / 87178291200.0)))))));
    const int q = ((int)n) & 3;
    const double ss = (q == 0) ? sp : (q == 1) ? cp : (q == 2) ? -sp : -cp;
    const double cc = (q == 0) ? cp : (q == 1) ? -sp : (q == 2) ? -cp : sp;
    s = (float)ss; c = (float)cc;
}

__device__ void prep_tables(const Params& p) {
    float* tab = (float*)(p.ws + WS_TAB);
    const int tid = otid();
    for (int idx = tid; idx < 1536; idx += 512) {
        int pos, i; float freq;
        if (idx < 1024) { pos = idx >> 4; i = idx & 15; freq = exp2f(-(float)i * (13.287712379549449f / 16.f)); }
        else { const int j = idx - 1024; pos = j >> 3; i = j & 7; freq = exp2f(-(float)i * (13.287712379549449f / 8.f)); }
        const float ang = (float)pos * freq;
        float s, c; sincos_acc(ang, s, c);
        if (idx < 1024) { tab[idx] = c; tab[1024 + idx] = s; }
        else { tab[2048 + (idx - 1024)] = c; tab[2560 + (idx - 1024)] = s; }
    }
    if (tid < 128) {
        const int l = tid >> 6, lane = tid & 63;
        float* cst = tab + 3072 + l * 32;
        float s1 = 0.f, s2 = 0.f;
        if (lane < 32) { s1 = p.in[15][l * 32 + lane] * p.in[16][l * 32 + lane]; s2 = p.in[17][l * 32 + lane] * p.in[18][l * 32 + lane]; }
        s1 = wave_sum(s1); s2 = wave_sum(s2);
        float maq = fabsf(p.in[10][l * 64 + lane]), mak = fabsf(p.in[11][l * 64 + lane]), mdq = fabsf(p.in[23][l * 64 + lane]), mdk = fabsf(p.in[24][l * 64 + lane]);
        float mbq = fabsf(p.in[13][l * 32 + (lane & 31)]), mbk = fabsf(p.in[14][l * 32 + (lane & 31)]);
        float mr = 0.f;
        for (int i = lane; i < 4 * 465; i += 64) mr = fmaxf(mr, fabsf(p.in[25][l * 1860 + i]));
        for (int o = 32; o > 0; o >>= 1) {
            maq = fmaxf(maq, __shfl_xor(maq, o)); mak = fmaxf(mak, __shfl_xor(mak, o)); mdq = fmaxf(mdq, __shfl_xor(mdq, o)); mdk = fmaxf(mdk, __shfl_xor(mdk, o));
            mbq = fmaxf(mbq, __shfl_xor(mbq, o)); mbk = fmaxf(mbk, __shfl_xor(mbk, o)); mr = fmaxf(mr, __shfl_xor(mr, o));
        }
        if (lane == 0) {
            const float li = 0.8f - 0.6f * expf(-0.3f * (float)l);
            cst[0] = expf(s1) - expf(s2) + li;
            cst[1] = 1.f - li;
            cst[2] = 8.f * maq * mak * LOG2E;
            cst[3] = 5.656854249492381f * mbq * mbk * LOG2E;
            cst[4] = (8.f * mdq * mdk + mr) * LOG2E;
        }
        if (lane < 4) {
            cst[8 + lane] = -log1pf(expf(-p.in[20][l * 4 + lane])) * LOG2E;
            cst[12 + lane] = -log1pf(expf(-p.in[21][l * 4 + lane])) * LOG2E;
            cst[16 + lane] = p.in[12][l * 4 + lane] * LOG2E;
        }
    }
}

__device__ void mod_item(const Params& p, int item, unsigned char* lds) {
    float* sv = (float*)lds;
    float* red = sv + 5 * 1024;
    const int tid = otid(), l = item / 96, n0 = (item % 96) * 64;
    for (int idx = tid; idx < 5 * 1024; idx += 512) {
        const int j = idx >> 10, k = idx & 1023;
        const float c = (j < 4) ? p.in[1][j * 1024 + k] : p.in[3][k];
        sv[idx] = c / (1.f + expf(-c));
    }
    __syncthreads();
    const int col = tid & 63, kg = tid >> 6;
    const float* w = p.in[4] + (size_t)l * 1024 * 6144 + (size_t)(kg * 128) * 6144 + n0 + col;
    float a0 = 0.f, a1 = 0.f, a2 = 0.f, a3 = 0.f, a4 = 0.f;
#pragma unroll 16
    for (int k = 0; k < 128; ++k) {
        const float wv = __builtin_nontemporal_load(w + (size_t)k * 6144);
        const int kk = kg * 128 + k;
        a0 += sv[kk] * wv; a1 += sv[1024 + kk] * wv; a2 += sv[2048 + kk] * wv; a3 += sv[3072 + kk] * wv; a4 += sv[4096 + kk] * wv;
    }
    red[(kg * 5 + 0) * 64 + col] = a0; red[(kg * 5 + 1) * 64 + col] = a1; red[(kg * 5 + 2) * 64 + col] = a2;
    red[(kg * 5 + 3) * 64 + col] = a3; red[(kg * 5 + 4) * 64 + col] = a4;
    __syncthreads();
    if (tid < 320) {
        const int j = tid >> 6, c = tid & 63;
        float s = p.in[5][l * 6144 + n0 + c];
        for (int g = 0; g < 8; ++g) s += red[(g * 5 + j) * 64 + c];
        ((float*)(p.ws + WS_MOD))[(l * 5 + j) * 6144 + n0 + c] = s;
    }
    __syncthreads();
}

__device__ void conv_layer(const Params& p, int l, unsigned char* lds, int lo, int hi, int bfirst, int nblk) {
    const int tid = otid(), grp = tid >> 7, t = tid & 127;
    float* tl = (float*)lds + grp * (64 * 65);
    bf16_t* wb = (bf16_t*)(p.ws + WS_W);
    if ((int)blockIdx.x < bfirst || (int)blockIdx.x >= bfirst + nblk) return;
    for (int it0 = lo + ((int)blockIdx.x - bfirst) * 4; it0 < hi; it0 += nblk * 4) {
        const int it = it0 + grp;
        const float* W; bf16_t* WT; int K, N, tile;
        if (it < 768) { W = p.in[8] + (size_t)l * 1024 * 3072; WT = (bf16_t*)((unsigned char*)wb + W_IN_OFF); K = 1024; N = 3072; tile = it; }
        else if (it < 1024) { W = p.in[9] + (size_t)l * 1024 * 1024; WT = (bf16_t*)((unsigned char*)wb + W_OUT_OFF); K = 1024; N = 1024; tile = it - 768; }
        else if (it < 2048) { W = p.in[26] + (size_t)l * 1024 * 4096; WT = (bf16_t*)((unsigned char*)wb + W_1_OFF); K = 1024; N = 4096; tile = it - 1024; }
        else { W = p.in[27] + (size_t)l * 4096 * 1024; WT = (bf16_t*)((unsigned char*)wb + W_2_OFF); K = 4096; N = 1024; tile = it - 2048; }
        const int nkt = K / 64, kt = tile % nkt, nt = tile / nkt, k0 = kt * 64, n0 = nt * 64;
        f32x4 v[8];
#pragma unroll
        for (int i = 0; i < 8; ++i) { const int idx = t + i * 128, k = idx >> 4, c4 = idx & 15; v[i] = *(const f32x4*)(W + (size_t)(k0 + k) * N + n0 + c4 * 4); }
#pragma unroll
        for (int i = 0; i < 8; ++i) { const int idx = t + i * 128, k = idx >> 4, c4 = idx & 15;
            tl[k * 65 + c4 * 4 + 0] = v[i][0]; tl[k * 65 + c4 * 4 + 1] = v[i][1]; tl[k * 65 + c4 * 4 + 2] = v[i][2]; tl[k * 65 + c4 * 4 + 3] = v[i][3]; }
        __syncthreads();
#pragma unroll
        for (int i = 0; i < 4; ++i) {
            const int idx = t + i * 128, n = idx >> 3, kc = idx & 7;
            float w[8];
#pragma unroll
            for (int j = 0; j < 8; ++j) w[j] = tl[(kc * 8 + j) * 65 + n];
            *(bf16x8*)(WT + (size_t)(n0 + n) * K + k0 + kc * 8) = pack8(w[0], w[1], w[2], w[3], w[4], w[5], w[6], w[7]);
        }
        __syncthreads();
    }
}

__device__ void norm_phase(const float* lat, const float* ctxb, const float* g, const float* mod, int shoff, int scoff, bf16_t* act, bool skip_ctx,
                           const float* slab = nullptr, int nsplit = 0, const float* gatec = nullptr, float* ctx_wb = nullptr, const float* slab2 = nullptr) {
    const int tid = otid(), lane = tid & 63, gw = blockIdx.x * 8 + (tid >> 6), nw = gridDim.x * 8;
    f32x4 gg[4], sh[4], sc[4], v[4], nx[4];
#pragma unroll
    for (int i = 0; i < 4; ++i) gg[i] = *(const f32x4*)(g + i * 256 + lane * 4);
    if (!skip_ctx) {
        const float* mj = mod + 4 * 6144;
        bool have = false;
        for (int cr = gw; cr < NB * CTX; cr += nw) {
            const int b = cr >> 8, t = cr & 255, R = b * T + t;
            if (!have) {
                have = true;
#pragma unroll
                for (int i = 0; i < 4; ++i) { sh[i] = *(const f32x4*)(mj + shoff + i * 256 + lane * 4); sc[i] = *(const f32x4*)(mj + scoff + i * 256 + lane * 4); }
            }
#pragma unroll
            for (int i = 0; i < 4; ++i) v[i] = *(const f32x4*)(ctxb + (size_t)cr * D + i * 256 + lane * 4);
            if (nsplit > 0) {
#pragma unroll
                for (int i = 0; i < 4; ++i) {
                    f32x4 acc = {0.f, 0.f, 0.f, 0.f};
                    for (int sp = 0; sp < nsplit; ++sp) { const f32x4 pv = *(const f32x4*)((sp < 4 ? slab : slab2) + ((size_t)(((sp & 3) * 16 + b * 4 + i) * 256 + t)) * 256 + lane * 4); acc += pv; }
                    const f32x4 gt = *(const f32x4*)(gatec + i * 256 + lane * 4);
                    v[i] += gt * acc;
                    if (ctx_wb) *(f32x4*)(ctx_wb + (size_t)cr * D + i * 256 + lane * 4) = v[i];
                }
            }
            float ss = 0.f;
#pragma unroll
            for (int i = 0; i < 4; ++i) ss += v[i][0] * v[i][0] + v[i][1] * v[i][1] + v[i][2] * v[i][2] + v[i][3] * v[i][3];
            ss = wave_sum(ss);
            const float rstd = rsqrtf(ss * (1.f / 1024.f) + EPS);
#pragma unroll
            for (int i = 0; i < 4; ++i) {
                float y[4];
#pragma unroll
                for (int e = 0; e < 4; ++e) y[e] = v[i][e] * rstd * gg[i][e] * (1.f + sc[i][e]) + sh[i][e];
                u32x2 o = {pk2(y[0], y[1]), pk2(y[2], y[3])};
                *(u32x2*)(act + (size_t)R * D + i * 256 + lane * 4) = o;
            }
        }
    }
    const int per = (NB * SEQ + nw - 1) / nw;
    int Rl = gw * per; const int Rend = min(NB * SEQ, Rl + per);
    if (Rl >= Rend) return;
    int curb = -1;
#pragma unroll
    for (int i = 0; i < 4; ++i) v[i] = __builtin_nontemporal_load((const f32x4*)(lat + (size_t)Rl * D + i * 256 + lane * 4));
    for (; Rl < Rend; ++Rl) {
        if (Rl + 1 < Rend) {
#pragma unroll
            for (int i = 0; i < 4; ++i) nx[i] = __builtin_nontemporal_load((const f32x4*)(lat + (size_t)(Rl + 1) * D + i * 256 + lane * 4));
        }
        const int b = Rl >> 12, R = b * T + CTX + (Rl & 4095);
        if (b != curb) {
            curb = b;
            const float* mj = mod + b * 6144;
#pragma unroll
            for (int i = 0; i < 4; ++i) { sh[i] = *(const f32x4*)(mj + shoff + i * 256 + lane * 4); sc[i] = *(const f32x4*)(mj + scoff + i * 256 + lane * 4); }
        }
        float ss = 0.f;
#pragma unroll
        for (int i = 0; i < 4; ++i) ss += v[i][0] * v[i][0] + v[i][1] * v[i][1] + v[i][2] * v[i][2] + v[i][3] * v[i][3];
        ss = wave_sum(ss);
        const float rstd = rsqrtf(ss * (1.f / 1024.f) + EPS);
#pragma unroll
        for (int i = 0; i < 4; ++i) {
            float y[4];
#pragma unroll
            for (int e = 0; e < 4; ++e) y[e] = v[i][e] * rstd * gg[i][e] * (1.f + sc[i][e]) + sh[i][e];
            u32x2 o = {pk2(y[0], y[1]), pk2(y[2], y[3])};
            *(u32x2*)(act + (size_t)R * D + i * 256 + lane * 4) = o;
        }
#pragma unroll
        for (int i = 0; i < 4; ++i) v[i] = nx[i];
    }
}

struct EpiArgs {
    const float* lat_in; const float* ctx_in; float* lat_out; float* ctx_out; const float* gate;
    bf16_t* out; int ldo;
    bf16_t* vt; bf16_t* kfb; bf16_t* kg8; unsigned* kvcnt; const float* aq; const float* ak; const float* bq; const float* bk; const float* dq; const float* dk; const float* tab;
};
enum { EPI_RESID = 0, EPI_RELU2 = 1, EPI_INPROJ = 2 };

DI void inproj_slab(const EpiArgs& ea, int cgi, const float* st, int Rbase, int lane) {
    int kind; const float* g = nullptr; float scale = 1.f; int vt_grp = -1;
    if (cgi < 4) { kind = 0; g = ea.aq; scale = 0.125f * LOG2E; }
    else if (cgi < 6) { kind = 0; g = ea.ak; }
    else if (cgi < 8) { kind = 5; vt_grp = cgi - 6; }
    else if (cgi < 12) { kind = 1; g = ea.bq; scale = 0.17677669529663687f * LOG2E; }
    else if (cgi < 16) { kind = 1; g = ea.bk; }
    else if (cgi < 20) { kind = 5; vt_grp = 2 + cgi - 16; }
    else if (cgi < 24) { kind = 3; }
    else if (cgi < 28) { kind = 3; scale = 0.125f; vt_grp = 14 + cgi - 24; }
    else if (cgi < 32) { kind = 5; vt_grp = 6 + cgi - 28; }
    else if (cgi < 36) { kind = 4; }
    else if (cgi < 40) { kind = 2; g = ea.dq; scale = 0.125f * LOG2E; }
    else if (cgi < 44) { kind = 2; g = ea.dk; }
    else { kind = 5; vt_grp = 10 + cgi - 44; }

    if (kind != 5) {
        const int row = lane >> 1, half = lane & 1, R = Rbase + row, b = R / T, t = R - b * T;
        const bool lat = t >= CTX; const int pos = t - CTX, pr = pos >> 6, pc = pos & 63;
        float v[32];
#pragma unroll
        for (int j = 0; j < 8; ++j) { const f32x4 q = *(const f32x4*)(st + row * 68 + half * 32 + j * 4); v[4 * j] = q[0]; v[4 * j + 1] = q[1]; v[4 * j + 2] = q[2]; v[4 * j + 3] = q[3]; }
        if (kind == 0 || kind == 2) {
            float ss = 0.f;
#pragma unroll
            for (int i = 0; i < 32; ++i) ss += v[i] * v[i];
            ss += __shfl_xor(ss, 1);
            const float rstd = rsqrtf(ss * (1.f / 64.f) + EPS);
#pragma unroll
            for (int i = 0; i < 32; ++i) v[i] *= rstd * g[half * 32 + i];
            if (kind == 0 && lat) {
                const int pp = half ? pc : pr;
                const float* tc = ea.tab + pp * 16; const float* ts = ea.tab + 1024 + pp * 16;
#pragma unroll
                for (int i = 0; i < 16; ++i) { const float c = tc[i], s = ts[i], x1 = v[i], x2 = v[i + 16]; v[i] = x1 * c - x2 * s; v[i + 16] = x1 * s + x2 * c; }
            }
        } else if (kind == 1) {
            float ss = 0.f;
#pragma unroll
            for (int i = 0; i < 32; ++i) ss += v[i] * v[i];
            const float rstd = rsqrtf(ss * (1.f / 32.f) + EPS);
#pragma unroll
            for (int i = 0; i < 32; ++i) v[i] *= rstd * g[i];
            if (lat) {
                const float* tcr = ea.tab + 2048 + pr * 8; const float* tsr = ea.tab + 2560 + pr * 8;
                const float* tcc = ea.tab + 2048 + pc * 8; const float* tsc = ea.tab + 2560 + pc * 8;
#pragma unroll
                for (int i = 0; i < 8; ++i) {
                    { const float c = tcr[i], s = tsr[i], x1 = v[i], x2 = v[i + 8]; v[i] = x1 * c - x2 * s; v[i + 8] = x1 * s + x2 * c; }
                    { const float c = tcc[i], s = tsc[i], x1 = v[16 + i], x2 = v[24 + i]; v[16 + i] = x1 * c - x2 * s; v[24 + i] = x1 * s + x2 * c; }
                }
            }
        } else if (kind == 4) {
#pragma unroll
            for (int i = 0; i < 32; ++i) v[i] = v[i] / (1.f + __expf(-v[i]));
        }
        bf16_t* dst = ea.out + (size_t)R * NIN + cgi * 64 + half * 32;
#pragma unroll
        for (int j = 0; j < 4; ++j)
            *(bf16x8*)(dst + j * 8) = pack8(v[8 * j] * scale, v[8 * j + 1] * scale, v[8 * j + 2] * scale, v[8 * j + 3] * scale, v[8 * j + 4] * scale, v[8 * j + 5] * scale, v[8 * j + 6] * scale, v[8 * j + 7] * scale);
    }
    if (vt_grp >= 0) {
        const int b = Rbase / T, t0 = Rbase - b * T;
        float v[32];
#pragma unroll
        for (int rr = 0; rr < 32; ++rr) v[rr] = st[rr * 68 + lane] * scale;
        bf16_t* dst = ea.vt + ((size_t)(b * NGRP + vt_grp) * 64 + lane) * T + t0;
#pragma unroll
        for (int j = 0; j < 4; ++j)
            *(bf16x8*)(dst + j * 8) = pack8(v[8 * j], v[8 * j + 1], v[8 * j + 2], v[8 * j + 3], v[8 * j + 4], v[8 * j + 5], v[8 * j + 6], v[8 * j + 7]);
    }
}

template <int EPI>
__device__ void gemm_phase(const bf16_t* __restrict__ A, const bf16_t* __restrict__ Bt, int K, int N, const EpiArgs& ea, unsigned char* lds, bool skip_ctx) {
    const int tid = otid(), wid = tid >> 6, lane = tid & 63, r = lane & 31, h = lane >> 5, wr = wid >> 2, wc = wid & 3;
    const int nN = N / 256, ntiles = 68 * nN, nk = K / 32;
    const int lrow = tid >> 2, lkc = tid & 3;
    for (int tile = blockIdx.x; tile < ntiles; tile += gridDim.x) {
        const int pm = tile % 68, pn = tile / 68;
        if (skip_ctx && (pm % 17 == 0)) continue;
        const int m0 = pm * 256, n0 = pn * 256;
        f32x16 acc[4][2];
#pragma unroll
        for (int i = 0; i < 4; ++i) { acc[i][0] = zero16(); acc[i][1] = zero16(); }
        const bf16_t* ga = A + (size_t)(m0 + lrow) * K + lkc * 8;
        const bf16_t* gb = Bt + (size_t)(n0 + lrow) * K + lkc * 8;
        const int loff = lrow * LDS_PITCH + lkc * 16;
        u32x4 ra[2], rb[2];
#pragma unroll
        for (int i = 0; i < 2; ++i) { ra[i] = *(const u32x4*)(ga + (size_t)i * 128 * K); rb[i] = *(const u32x4*)(gb + (size_t)i * 128 * K); }
#pragma unroll
        for (int i = 0; i < 2; ++i) { *(u32x4*)(lds + loff + i * 128 * LDS_PITCH) = ra[i]; *(u32x4*)(lds + STAGE_MAT + loff + i * 128 * LDS_PITCH) = rb[i]; }
        __syncthreads();
#pragma unroll
        for (int i = 0; i < 2; ++i) { ra[i] = *(const u32x4*)(ga + (size_t)i * 128 * K + 32); rb[i] = *(const u32x4*)(gb + (size_t)i * 128 * K + 32); }
#pragma unroll 1
        for (int kt = 0; kt < nk; ++kt) {
            const unsigned char* sa = lds + (kt & 1) * 2 * STAGE_MAT;
            const unsigned char* sb = sa + STAGE_MAT;
#pragma unroll
            for (int ks = 0; ks < 2; ++ks) {
                bf16x8 af[4], bfr[2];
#pragma unroll
                for (int mb = 0; mb < 4; ++mb) af[mb] = *(const bf16x8*)(sa + (wr * 128 + mb * 32 + r) * LDS_PITCH + ks * 32 + h * 16);
#pragma unroll
                for (int nb = 0; nb < 2; ++nb) bfr[nb] = *(const bf16x8*)(sb + (wc * 64 + nb * 32 + r) * LDS_PITCH + ks * 32 + h * 16);
#pragma unroll
                for (int mb = 0; mb < 4; ++mb)
#pragma unroll
                    for (int nb = 0; nb < 2; ++nb) acc[mb][nb] = mfma(af[mb], bfr[nb], acc[mb][nb]);
            }
            if (kt + 1 < nk) {
                unsigned char* da = lds + ((kt + 1) & 1) * 2 * STAGE_MAT;
#pragma unroll
                for (int i = 0; i < 2; ++i) { *(u32x4*)(da + loff + i * 128 * LDS_PITCH) = ra[i]; *(u32x4*)(da + STAGE_MAT + loff + i * 128 * LDS_PITCH) = rb[i]; }
            }
            __syncthreads();
            if (kt + 2 < nk) {
#pragma unroll
                for (int i = 0; i < 2; ++i) { ra[i] = *(const u32x4*)(ga + (size_t)i * 128 * K + (kt + 2) * 32); rb[i] = *(const u32x4*)(gb + (size_t)i * 128 * K + (kt + 2) * 32); }
            }
        }
        {
            float* st = (float*)(lds + wid * 8704);
            const int cgi = (n0 + wc * 64) >> 6;
#pragma unroll
            for (int mb = 0; mb < 4; ++mb) {
                __syncthreads();
#pragma unroll
                for (int nb = 0; nb < 2; ++nb)
#pragma unroll
                    for (int i = 0; i < 16; ++i) st[crow(i, h) * 68 + nb * 32 + r] = acc[mb][nb][i];
                __syncthreads();
                const int Rbase = m0 + wr * 128 + mb * 32;
                if (EPI == EPI_INPROJ) inproj_slab(ea, cgi, st, Rbase, lane);
                else if (EPI == EPI_RESID) {
                    const int row = lane >> 1, half = lane & 1;
                    const int b = pm / 17, tt = pm % 17;
                    const float* gate = ea.gate + ((tt == 0) ? 4 : b) * 6144 + n0 + wc * 64 + half * 32;
                    const int trow = wr * 128 + mb * 32 + row;
                    size_t o;
                    const float* rin; float* rout;
                    if (tt == 0) { o = ((size_t)b * CTX + trow) * D; rin = ea.ctx_in; rout = ea.ctx_out; }
                    else { o = ((size_t)b * SEQ + (size_t)(tt - 1) * 256 + trow) * D; rin = ea.lat_in; rout = ea.lat_out; }
                    o += n0 + wc * 64 + half * 32;
#pragma unroll
                    for (int j = 0; j < 8; ++j) {
                        const f32x4 q = *(const f32x4*)(st + row * 68 + half * 32 + j * 4);
                        const f32x4 gv = *(const f32x4*)(gate + j * 4);
                        const f32x4 xi = *(const f32x4*)(rin + o + j * 4);
                        f32x4 y; y[0] = xi[0] + gv[0] * q[0]; y[1] = xi[1] + gv[1] * q[1]; y[2] = xi[2] + gv[2] * q[2]; y[3] = xi[3] + gv[3] * q[3];
                        *(f32x4*)(rout + o + j * 4) = y;
                    }
                } else {
                    const int row = lane >> 1, half = lane & 1;
                    float v[32];
#pragma unroll
                    for (int j = 0; j < 8; ++j) { const f32x4 q = *(const f32x4*)(st + row * 68 + half * 32 + j * 4); v[4 * j] = q[0]; v[4 * j + 1] = q[1]; v[4 * j + 2] = q[2]; v[4 * j + 3] = q[3]; }
#pragma unroll
                    for (int i = 0; i < 32; ++i) { const float x = fmaxf(v[i], 0.f); v[i] = x * x; }
                    bf16_t* dst = ea.out + (size_t)(Rbase + row) * ea.ldo + n0 + wc * 64 + half * 32;
#pragma unroll
                    for (int j = 0; j < 4; ++j)
                        *(bf16x8*)(dst + j * 8) = pack8(v[8 * j], v[8 * j + 1], v[8 * j + 2], v[8 * j + 3], v[8 * j + 4], v[8 * j + 5], v[8 * j + 6], v[8 * j + 7]);
                }
            }
            __syncthreads();
        }
    }
}

namespace g8 {
constexpr int BM = 256, BK = 64, HALF = 128, HT = HALF * BK, SPITCH = 260;
DI int lds_byte(int r, int c) { const int st = (r >> 4) * 2 + (c >> 5), rr = r & 15, cc = c & 31, ob = rr * 64 + cc * 2; return st * 1024 + (ob ^ (((ob >> 9) & 1) << 5)); }
DI void stage_rc(int b, int& R, int& C) { const int st = b / 1024, sb = b % 1024, swz = sb ^ (((sb >> 9) & 1) << 5); R = (st >> 1) * 16 + swz / 64; C = (st & 1) * 32 + (swz % 64) / 2; }
}

DI void inproj_pass(const EpiArgs& ea, LAS float* st, int cgl, int cgi, int rw  , int lane, int Rtile  ) {
    int kind; const float* g = nullptr; float scale = 1.f; int vt_grp = -1;
    if (cgi < 4) { kind = 0; g = ea.aq; scale = 0.125f * LOG2E; }
    else if (cgi < 6) { kind = 0; g = ea.ak; }
    else if (cgi < 8) { kind = 5; vt_grp = cgi - 6; }
    else if (cgi < 12) { kind = 1; g = ea.bq; scale = 0.17677669529663687f * LOG2E; }
    else if (cgi < 16) { kind = 1; g = ea.bk; }
    else if (cgi < 20) { kind = 5; vt_grp = 2 + cgi - 16; }
    else if (cgi < 24) { kind = 3; }
    else if (cgi < 28) { kind = 3; scale = 0.125f; vt_grp = 14 + cgi - 24; }
    else if (cgi < 32) { kind = 5; vt_grp = 6 + cgi - 28; }
    else if (cgi < 36) { kind = 4; }
    else if (cgi < 40) { kind = 2; g = ea.dq; scale = 0.125f * LOG2E; }
    else if (cgi < 44) { kind = 2; g = ea.dk; }
    else { kind = 5; vt_grp = 10 + cgi - 44; }
    if (vt_grp >= 0) {
        const int R0 = Rtile + rw * 64, b = R0 / T, t0 = R0 - b * T;
        bf16_t* dst = ea.vt + ((size_t)(b * NGRP + vt_grp) * 64 + lane) * T + t0;
#pragma unroll 1
        for (int hf = 0; hf < 2; ++hf) {
            float v[32];
#pragma unroll
            for (int rr = 0; rr < 32; ++rr) v[rr] = st[(rw * 64 + hf * 32 + rr) * g8::SPITCH + cgl * 64 + lane] * scale;
            if (vt_grp >= 2 && vt_grp < 6) {
                bf16_t* fd = ea.vt + (size_t)(b * NGRP + vt_grp) * 64 * T + (size_t)((t0 >> 5) + hf) * 2048 + (lane >> 5) * 1024 + (lane & 31) * 8;
#pragma unroll
                for (int j = 0; j < 4; ++j)
                    *(bf16x8*)(fd + (j >> 1) * 512 + (j & 1) * 256) = pack8(v[8 * j], v[8 * j + 1], v[8 * j + 2], v[8 * j + 3], v[8 * j + 4], v[8 * j + 5], v[8 * j + 6], v[8 * j + 7]);
            } else if (true) {
                bf16_t* fd = ea.vt + (size_t)(b * NGRP + vt_grp) * 64 * T + (size_t)((t0 >> 3) + hf * 4) * 512 + (lane >> 5) * 256 + (lane & 31) * 8;
#pragma unroll
                for (int j = 0; j < 4; ++j) {
                    const bf16x8 w8 = pack8(v[8 * j], v[8 * j + 1], v[8 * j + 2], v[8 * j + 3], v[8 * j + 4], v[8 * j + 5], v[8 * j + 6], v[8 * j + 7]);
                    if ((vt_grp >= 6 && vt_grp < 10) || vt_grp >= 14) stwt16(fd + j * 512, w8); else *(bf16x8*)(fd + j * 512) = w8;
                }
            } else {
#pragma unroll
                for (int j = 0; j < 4; ++j)
                    *(bf16x8*)(dst + hf * 32 + j * 8) = pack8(v[8 * j], v[8 * j + 1], v[8 * j + 2], v[8 * j + 3], v[8 * j + 4], v[8 * j + 5], v[8 * j + 6], v[8 * j + 7]);
            }
        }
    }
    if (vt_grp >= 0 && kind != 5) { asm volatile("s_waitcnt lgkmcnt(0)" ::: "memory"); __builtin_amdgcn_wave_barrier(); }
    if (kind != 5) {
        const int row = rw * 64 + lane, R = Rtile + row, b = R / T, t = R - b * T;
        const bool lat = t >= CTX; const int pos = t - CTX, pr = pos >> 6, pc = pos & 63;
        LAS float* srow = st + row * g8::SPITCH + cgl * 64;
        float ss64 = 0.f;
        if (kind == 0 || kind == 2) {
#pragma unroll
            for (int j = 0; j < 16; ++j) { const f32x4 q = *(const LAS f32x4*)(srow + j * 4); ss64 += q[0] * q[0] + q[1] * q[1] + q[2] * q[2] + q[3] * q[3]; }
        }
        const float rstd64 = rsqrtf(ss64 * (1.f / 64.f) + EPS);
        bf16_t* dst = ea.out + (size_t)R * NIN + cgi * 64;
#pragma unroll 1
        for (int hf = 0; hf < 2; ++hf) {
            float v[32];
#pragma unroll
            for (int j = 0; j < 8; ++j) { const f32x4 q = *(const LAS f32x4*)(srow + hf * 32 + j * 4); v[4 * j] = q[0]; v[4 * j + 1] = q[1]; v[4 * j + 2] = q[2]; v[4 * j + 3] = q[3]; }
            if (kind == 0 || kind == 2) {
#pragma unroll
                for (int i = 0; i < 32; ++i) v[i] *= rstd64 * g[hf * 32 + i];
                if (kind == 0 && lat) {
                    const int pp = hf ? pc : pr;
                    const float* tc = ea.tab + pp * 16; const float* ts = ea.tab + 1024 + pp * 16;
#pragma unroll
                    for (int i = 0; i < 16; ++i) { const float c = tc[i], sn = ts[i], x1 = v[i], x2 = v[i + 16]; v[i] = x1 * c - x2 * sn; v[i + 16] = x1 * sn + x2 * c; }
                }
            } else if (kind == 1) {
                float ss = 0.f;
#pragma unroll
                for (int i = 0; i < 32; ++i) ss += v[i] * v[i];
                const float rstd = rsqrtf(ss * (1.f / 32.f) + EPS);
#pragma unroll
                for (int i = 0; i < 32; ++i) v[i] *= rstd * g[i];
                if (lat) {
                    const float* tcr = ea.tab + 2048 + pr * 8; const float* tsr = ea.tab + 2560 + pr * 8;
                    const float* tcc = ea.tab + 2048 + pc * 8; const float* tsc = ea.tab + 2560 + pc * 8;
#pragma unroll
                    for (int i = 0; i < 8; ++i) {
                        { const float c = tcr[i], sn = tsr[i], x1 = v[i], x2 = v[i + 8]; v[i] = x1 * c - x2 * sn; v[i + 8] = x1 * sn + x2 * c; }
                        { const float c = tcc[i], sn = tsc[i], x1 = v[16 + i], x2 = v[24 + i]; v[16 + i] = x1 * c - x2 * sn; v[24 + i] = x1 * sn + x2 * c; }
                    }
                }
            } else if (kind == 4) {
#pragma unroll
                for (int i = 0; i < 32; ++i) v[i] = v[i] / (1.f + __expf(-v[i]));
            }
            if (cgi >= 12 && cgi < 16) {
                const int tile = t >> 5, kk = t & 31, rinv = ((kk >> 4) & 1) * 16 + ((kk >> 2) & 1) * 8 + ((kk >> 3) & 1) * 4 + (kk & 3);
                bf16_t* fd = ea.kfb + ((size_t)((b * 4 + (cgi - 12)) * 136 + tile)) * 2048 + hf * 1024 + rinv * 8;
#pragma unroll
                for (int j = 0; j < 4; ++j)
                    *(bf16x8*)(fd + (j >> 1) * 512 + (j & 1) * 256) = pack8(v[8 * j] * scale, v[8 * j + 1] * scale, v[8 * j + 2] * scale, v[8 * j + 3] * scale, v[8 * j + 4] * scale, v[8 * j + 5] * scale, v[8 * j + 6] * scale, v[8 * j + 7] * scale);
            } else if ((cgi >= 4 && cgi < 6) || (cgi >= 40 && cgi < 44)) {
                const int kh = (cgi < 6) ? (cgi - 4) : (2 + cgi - 40);
                bf16_t* fd = ea.kg8 + (size_t)(b * 6 + kh) * 64 * T + (size_t)(t >> 3) * 512 + hf * 256 + (t & 7) * 8;
#pragma unroll
                for (int j = 0; j < 4; ++j)
                    *(bf16x8*)(fd + (j >> 1) * 128 + (j & 1) * 64) = pack8(v[8 * j] * scale, v[8 * j + 1] * scale, v[8 * j + 2] * scale, v[8 * j + 3] * scale, v[8 * j + 4] * scale, v[8 * j + 5] * scale, v[8 * j + 6] * scale, v[8 * j + 7] * scale);
            } else {
                LAS bf16x8* seg = (LAS bf16x8*)srow;
#pragma unroll
                for (int j = 0; j < 4; ++j)
                    seg[hf * 4 + j] = pack8(v[8 * j] * scale, v[8 * j + 1] * scale, v[8 * j + 2] * scale, v[8 * j + 3] * scale, v[8 * j + 4] * scale, v[8 * j + 5] * scale, v[8 * j + 6] * scale, v[8 * j + 7] * scale);
            }
        }
        const bool tokmajor = !((cgi >= 12 && cgi < 16) || (cgi >= 4 && cgi < 6) || (cgi >= 40 && cgi < 44));
        if (tokmajor) {
            asm volatile("s_waitcnt lgkmcnt(0)" ::: "memory");
            __builtin_amdgcn_wave_barrier();
#pragma unroll
            for (int itr = 0; itr < 8; ++itr) {
                const int row_l = itr * 8 + (lane >> 3), chunk = lane & 7;
                const bf16x8 w = *(const LAS bf16x8*)((const LAS unsigned char*)(st + (rw * 64 + row_l) * g8::SPITCH + cgl * 64) + chunk * 16);
                *(bf16x8*)(ea.out + (size_t)(Rtile + rw * 64 + row_l) * NIN + cgi * 64 + chunk * 8) = w;
            }
        }
    }
}

template <int EPI>
__device__ void gemm_phase8(const bf16_t* __restrict__ A, const bf16_t* __restrict__ Bt, const int K, const int N, const EpiArgs& ea, unsigned char* lds, const bool skip_ctx, const int nsplit = 0, float* slab = nullptr, float* slab2 = nullptr) {
    using namespace g8;
    LAS unsigned char* ldsl = (LAS unsigned char*)lds;
    const int tidx = otid();
    const int wid = __builtin_amdgcn_readfirstlane(tidx >> 6), lane = tidx & 63, wr = wid >> 2, wc = wid & 3, fr = lane & 15, fq = lane >> 4;
    int sr0, sc0; stage_rc(tidx * 16, sr0, sc0);
    const unsigned gb0 = (unsigned)(sr0 * K + sc0) * 2u, gb1 = gb0 + 128u * (unsigned)K;
    const int aoff = lds_byte(wr * 64 + fr, fq * 8), boff = lds_byte(wc * 32 + fr, fq * 8);
    const unsigned ldsw = (unsigned)tidx * 16u;
#define SA(b, h) (((b) * 2 + (h)) * 16384)
#define SB(b, h) ((4 + (b) * 2 + (h)) * 16384)
#define STAGE(P, BASE, br, kt) do { const char* _sb = (const char*)(BASE + ((long)(br) * K + kbeg + (long)(kt) * BK)); \
    unsigned _g0 = gb0, _g1 = gb1; asm volatile("" : "+v"(_g0), "+v"(_g1)); \
    __builtin_amdgcn_global_load_lds((const unsigned*)(_sb + _g0), (LAS unsigned*)(ldsl + (P) + ldsw), 16, 0, 0); \
    __builtin_amdgcn_global_load_lds((const unsigned*)(_sb + _g1), (LAS unsigned*)(ldsl + (P) + ldsw + 8192), 16, 0, 0); } while (0)
#define LDA(dst, b, h) _Pragma("unroll") for (int m = 0; m < 4; ++m) _Pragma("unroll") for (int k = 0; k < 2; ++k) \
    dst[m][k] = *(const LAS bf16x8*)(ldsl + SA(b, h) + aoff + m * 2048 + k * 1024)
#define LDB(dst, b, h) _Pragma("unroll") for (int n = 0; n < 2; ++n) _Pragma("unroll") for (int k = 0; k < 2; ++k) \
    dst[n][k] = *(const LAS bf16x8*)(ldsl + SB(b, h) + boff + n * 2048 + k * 1024)
#define MMA(ai, bj, At, Bx) do { __builtin_amdgcn_s_setprio(1); \
    _Pragma("unroll") for (int m = 0; m < 4; ++m) _Pragma("unroll") for (int n = 0; n < 2; ++n) _Pragma("unroll") for (int k = 0; k < 2; ++k) \
      acc[ai][bj][m][n] = __builtin_amdgcn_mfma_f32_16x16x32_bf16(At[m][k], Bx[n][k], acc[ai][bj][m][n], 0, 0, 0); \
    __builtin_amdgcn_s_setprio(0); } while (0)
#define WAIT_V(n) asm volatile("s_waitcnt vmcnt(" #n ")" ::: "memory")
#define WAIT_L(n) asm volatile("s_waitcnt lgkmcnt(" #n ")" ::: "memory")
#define BAR __builtin_amdgcn_s_barrier()
#define SCHED __builtin_amdgcn_sched_barrier(0)
    const int nMe = skip_ctx ? 64 : 68, nN = N / BM, ntiles = nMe * nN, nextra = nsplit * 4 * nN;
    for (int tile = blockIdx.x; tile < ntiles + nextra; tile += gridDim.x) {
        int pme, pn, kbeg = 0, nt = K / BK, pslot = -1;
        if (tile >= ntiles) {
            const int e = tile - ntiles, ct = e / nsplit, sidx = e - ct * nsplit;
            pme = (ct / nN) * 17; pn = ct % nN; nt = K / BK / nsplit; kbeg = sidx * nt * BK; pslot = e;
        } else {
            int wgid = tile; const int q = ntiles / 8, rr = ntiles % 8, xcd = wgid % 8, off = wgid / 8;
            wgid = (xcd < rr ? xcd * (q + 1) : rr * (q + 1) + (xcd - rr) * q) + off;
            const int nig = 8 * nN, gid = wgid / nig, fm = gid * 8, gsz = (nMe - fm) < 8 ? (nMe - fm) : 8;
            pme = fm + ((wgid % nig) % gsz); pn = (wgid % nig) / gsz;
        }
        const int pm = (skip_ctx && pslot < 0) ? (pme + pme / 16 + 1) : pme;
        const int brow = pm * BM, bcol = pn * BM;
        f32x4 acc[2][2][4][2];
#pragma unroll
        for (int a = 0; a < 2; ++a)
#pragma unroll
            for (int b = 0; b < 2; ++b)
#pragma unroll
                for (int m = 0; m < 4; ++m)
#pragma unroll
                    for (int n = 0; n < 2; ++n) acc[a][b][m][n] = (f32x4){0.f, 0.f, 0.f, 0.f};
        bf16x8 At[4][2], B0[2][2], B1[2][2];
        STAGE(SB(0, 0), Bt, bcol, 0); STAGE(SA(0, 0), A, brow, 0);
        STAGE(SB(0, 1), Bt, bcol + HALF, 0); STAGE(SA(0, 1), A, brow + HALF, 0);
        if (wr == 1) BAR;
        WAIT_V(4); BAR;
        STAGE(SB(1, 0), Bt, bcol, 1); STAGE(SA(1, 0), A, brow, 1); STAGE(SB(1, 1), Bt, bcol + HALF, 1);
        WAIT_V(6); BAR;
        for (int t = 0; t < nt - 2; t += 2) {
            LDB(B0, 0, 0); SCHED; LDA(At, 0, 0); STAGE(SA(1, 1), A, brow + HALF, t + 1);
            WAIT_L(8); BAR; WAIT_L(0); MMA(0, 0, At, B0); BAR; SCHED;
            LDB(B1, 0, 1); STAGE(SB(0, 0), Bt, bcol, t + 2);
            BAR; WAIT_L(0); MMA(0, 1, At, B1); BAR;
            LDA(At, 0, 1); STAGE(SA(0, 0), A, brow, t + 2);
            BAR; WAIT_L(0); MMA(1, 0, At, B0); BAR; SCHED;
            STAGE(SB(0, 1), Bt, bcol + HALF, t + 2);
            WAIT_V(6); BAR; MMA(1, 1, At, B1); BAR;
            LDB(B0, 1, 0); SCHED; LDA(At, 1, 0); STAGE(SA(0, 1), A, brow + HALF, t + 2);
            WAIT_L(8); BAR; WAIT_L(0); MMA(0, 0, At, B0); BAR; SCHED;
            LDB(B1, 1, 1); STAGE(SB(1, 0), Bt, bcol, t + 3);
            BAR; WAIT_L(0); MMA(0, 1, At, B1); BAR;
            LDA(At, 1, 1); STAGE(SA(1, 0), A, brow, t + 3);
            BAR; WAIT_L(0); MMA(1, 0, At, B0); BAR; SCHED;
            STAGE(SB(1, 1), Bt, bcol + HALF, t + 3);
            WAIT_V(6); BAR; MMA(1, 1, At, B1); BAR;
        }
        { LDB(B0, 0, 0); LDA(At, 0, 0); STAGE(SA(1, 1), A, brow + HALF, nt - 1);
          BAR; WAIT_L(0); MMA(0, 0, At, B0); BAR;
          LDB(B1, 0, 1); BAR; WAIT_L(0); MMA(0, 1, At, B1); BAR;
          LDA(At, 0, 1); WAIT_V(4); BAR; WAIT_L(0); MMA(1, 0, At, B0); MMA(1, 1, At, B1); BAR; }
        { LDB(B0, 1, 0); LDA(At, 1, 0); WAIT_V(2); BAR; WAIT_L(0); MMA(0, 0, At, B0); BAR;
          LDB(B1, 1, 1); WAIT_V(0); BAR; WAIT_L(0); MMA(0, 1, At, B1); BAR;
          LDA(At, 1, 1); BAR; WAIT_L(0); MMA(1, 0, At, B0); MMA(1, 1, At, B1); BAR; }
        if (wr == 0) BAR;
        __syncthreads();
        LAS float* st = (LAS float*)ldsl;
        const int etid = otid(), elane = etid & 63, ewid = __builtin_amdgcn_readfirstlane(etid >> 6);
#pragma unroll
        for (int ai = 0; ai < 2; ++ai) {
            if (ai) __syncthreads();
#pragma unroll
            for (int bj = 0; bj < 2; ++bj)
#pragma unroll
                for (int m = 0; m < 4; ++m)
#pragma unroll
                    for (int n = 0; n < 2; ++n)
#pragma unroll
                        for (int j = 0; j < 4; ++j) st[(wr * 64 + m * 16 + fq * 4 + j) * SPITCH + bj * 128 + wc * 32 + n * 16 + fr] = acc[ai][bj][m][n][j];
            __syncthreads();
            const int Rtile = brow + ai * 128;
            if (EPI == EPI_INPROJ) {
                inproj_pass(ea, st, ewid & 3, (bcol >> 6) + (ewid & 3), ewid >> 2, elane, Rtile);
            } else {
                const int b = pm / 17, tt = pm % 17;
                const float* gate = ea.gate + ((tt == 0) ? 4 : b) * 6144 + bcol;
                const float* rin; float* rout; size_t o0;
                if (tt == 0) { o0 = ((size_t)b * CTX + ai * 128) * D; rin = ea.ctx_in; rout = ea.ctx_out; }
                else { o0 = ((size_t)b * SEQ + (size_t)(tt - 1) * 256 + ai * 128) * D; rin = ea.lat_in; rout = ea.lat_out; }
#pragma unroll 4
                for (int i = 0; i < 16; ++i) {
                    const int f = etid + i * 512, row = f >> 6, c4 = f & 63;
                    const f32x4 q = *(const LAS f32x4*)(st + row * SPITCH + c4 * 4);
                    if (EPI == EPI_RESID && pslot >= 0) {
                        const int ct = pslot / nsplit, sidx = pslot - ct * nsplit;
                        *(f32x4*)((sidx < 4 ? slab : slab2) + ((size_t)(((sidx & 3) * 16 + ct) * 256 + ai * 128 + row)) * 256 + c4 * 4) = q;
                    } else if (EPI == EPI_RESID) {
                        const size_t o = o0 + (size_t)row * D + bcol + c4 * 4;
                        const f32x4 gv = *(const f32x4*)(gate + c4 * 4);
                        const f32x4 xi = *(const f32x4*)(rin + o);
                        f32x4 y; y[0] = xi[0] + gv[0] * q[0]; y[1] = xi[1] + gv[1] * q[1]; y[2] = xi[2] + gv[2] * q[2]; y[3] = xi[3] + gv[3] * q[3];
                        *(f32x4*)(rout + o) = y;
                    } else {
                        const float x0 = fmaxf(q[0], 0.f), x1 = fmaxf(q[1], 0.f), x2 = fmaxf(q[2], 0.f), x3 = fmaxf(q[3], 0.f);
                        u32x2 w = {pk2(x0 * x0, x1 * x1), pk2(x2 * x2, x3 * x3)};
                        *(u32x2*)(ea.out + (size_t)(Rtile + row) * ea.ldo + bcol + c4 * 4) = w;
                    }
                }
            }
        }
        if (EPI == EPI_INPROJ && ea.kvcnt != nullptr && (pn == 6 || pn == 7)) {
            asm volatile("s_waitcnt vmcnt(0)" ::: "memory");
            __syncthreads();
            if (etid == 0) __hip_atomic_fetch_add(ea.kvcnt, 1u, __ATOMIC_RELAXED, __HIP_MEMORY_SCOPE_AGENT);
        }
        __syncthreads();
    }
#undef SA
#undef SB
#undef STAGE
#undef LDA
#undef LDB
#undef MMA
#undef WAIT_V
#undef WAIT_L
#undef BAR
#undef SCHED
}

struct A64 { f32x16 o0, o1; float l; };
template <int KSD = 16>
DI void qk64(const bf16_t* kp, const bf16x8 (&qf)[4], f32x16& s) {
    s = zero16();
#pragma unroll
    for (int ks = 0; ks < 4; ++ks) s = mfma(ldg8(kp + ks * KSD), qf[ks], s);
}
template <int SL = 16, int DBO = 32 * T>
DI void pv64(const bf16_t* vp, bf16x8 p0, bf16x8 p1, f32x16& o0, f32x16& o1) {
    o0 = mfma(ldg8(vp), p0, o0);
    o0 = mfma(ldg8(vp + SL), p1, o0);
    o1 = mfma(ldg8(vp + DBO), p0, o1);
    o1 = mfma(ldg8(vp + DBO + SL), p1, o1);
}
DI int k8off(int tk, int r, int h) { const int key = keyperm(r); return ((tk >> 3) + (key >> 3)) * 512 + h * 64 + (key & 7) * 8; }
DI int v8off(int tk, int r, int h) { return ((tk >> 3) + h) * 512 + r * 8; }
DI void pack_p(const f32x16& s, bf16x8& p0, bf16x8& p1) {
    p0 = pack8(s[0], s[1], s[2], s[3], s[4], s[5], s[6], s[7]);
    p1 = pack8(s[8], s[9], s[10], s[11], s[12], s[13], s[14], s[15]);
}
DI void tile_plain(const bf16_t* kp, const bf16_t* vp, const bf16x8 (&qf)[4], float shift, A64& a) {
    f32x16 s; qk64<128>(kp, qf, s);
#pragma unroll
    for (int i = 0; i < 16; ++i) { const float p = ex2(s[i] - shift); a.l += p; s[i] = p; }
    bf16x8 p0, p1; pack_p(s, p0, p1); pv64<1024, 256>(vp, p0, p1, a.o0, a.o1);
}
DI void store_o64(bf16_t* dst, const f32x16& o0, const f32x16& o1, float mul) {
#pragma unroll
    for (int q4 = 0; q4 < 4; ++q4) {
        u32x2 a = {pk2(o0[4 * q4] * mul, o0[4 * q4 + 1] * mul), pk2(o0[4 * q4 + 2] * mul, o0[4 * q4 + 3] * mul)};
        u32x2 b = {pk2(o1[4 * q4] * mul, o1[4 * q4 + 1] * mul), pk2(o1[4 * q4 + 2] * mul, o1[4 * q4 + 3] * mul)};
        *(u32x2*)(dst + 8 * q4) = a; *(u32x2*)(dst + 32 + 8 * q4) = b;
    }
}

template <class TK, class SOFT>
DI void attn64_run(const bf16_t* kbase, const bf16_t* vbase, const bf16x8 (&qf)[4], int n, int r, int h, TK tk_of, SOFT soft, f32x16& o0, f32x16& o1, float& lsum) {
    bf16x8 ka[4], va[4], kb[4], vb[4];
#define A64_LOAD(KK, VV, i_) do { const int _t = tk_of(((i_) < n) ? (i_) : n - 1); const bf16_t* _kp = kbase + k8off(_t, r, h); const bf16_t* _vp = vbase + v8off(_t, r, h); \
        _Pragma("unroll") for (int ks = 0; ks < 4; ++ks) KK[ks] = ldg8(_kp + ks * 128); \
        VV[0] = ldg8(_vp); VV[1] = ldg8(_vp + 1024); VV[2] = ldg8(_vp + 256); VV[3] = ldg8(_vp + 1280); } while (0)
#define A64_STEP(KK, VV, KZ, VZ, i_) do { \
        A64_LOAD(KZ, VZ, (i_) + 1); \
        __builtin_amdgcn_sched_barrier(0); \
        f32x16 s_ = zero16(); \
        _Pragma("unroll") for (int ks = 0; ks < 4; ++ks) s_ = mfma(KK[ks], qf[ks], s_); \
        lsum += soft((i_), s_); \
        bf16x8 p0_, p1_; pack_p(s_, p0_, p1_); \
        o0 = mfma(VV[0], p0_, o0); o1 = mfma(VV[2], p0_, o1); o0 = mfma(VV[1], p1_, o0); o1 = mfma(VV[3], p1_, o1); \
        __builtin_amdgcn_sched_barrier(0); } while (0)
    A64_LOAD(ka, va, 0);
#pragma unroll 1
    for (int i = 0; i < n; i += 2) {
        A64_STEP(ka, va, kb, vb, i);
        if (i + 1 < n) A64_STEP(kb, vb, ka, va, i + 1);
    }
#undef A64_LOAD
#undef A64_STEP
}

struct MixArgs { const LAS float* rpb_l; const LAS float* gains_l;     const bf16_t* qkv; const bf16_t* vt; const bf16_t* kfb; const bf16_t* kg8; bf16_t* mix; const float* cst; const float* rpb; const float* subln; const float* gn; const bf16_t* sin; };

__device__ void attnA_item(const MixArgs& ma, int it, bool ctxq) {
    const int lane = otid() & 63, r = lane & 31, h = lane >> 5;
    int b, head, qb;
    if (!ctxq) { b = it >> 9; head = (it >> 7) & 3; qb = it & 127; } else { b = it >> 5; head = (it >> 3) & 3; qb = it & 7; }
    const int g = head >> 1;
    const int q0 = qb * 32;
    const int Rq = b * T + (ctxq ? 0 : CTX) + q0 + r;
    const float shift = ma.cst[2];
    bf16x8 qf[4];
#pragma unroll
    for (int ks = 0; ks < 4; ++ks) qf[ks] = ldg8(ma.qkv + (size_t)Rq * NIN + head * 64 + ks * 16 + h * 8);
    const bf16_t* kbase = ma.kg8 + (size_t)(b * 6 + g) * 64 * T;
    const bf16_t* vbase = ma.vt + (size_t)(b * NGRP + g) * 64 * T;
    A64 a; a.o0 = zero16(); a.o1 = zero16(); a.l = 0.f;
    {
        const int kt_lo = ctxq ? 0 : max(-4, -(q0 >> 5)), kt_hi = ctxq ? -1 : min(4, (SEQ - 32 - q0) >> 5), nwin = kt_hi - kt_lo + 1;
        auto tk_of = [&](int i) { return (i < nwin) ? (CTX + q0 + (kt_lo + i) * 32) : (i - nwin) * 32; };
        auto soft = [&](int i, f32x16& sc) {
            const int kt = (i < nwin) ? kt_lo + i : 0;
            float sum = 0.f;
#pragma unroll
            for (int e = 0; e < 16; ++e) {
                const int kk = kidx(e, h);
                const bool valid = (kt == -4) ? (kk >= r) : (kt == 4) ? (kk <= r) : true;
                const float pp = valid ? ex2(sc[e] - shift) : 0.f; sum += pp; sc[e] = pp;
            }
            return sum;
        };
        attn64_run(kbase, vbase, qf, nwin + 8, r, h, tk_of, soft, a.o0, a.o1, a.l);
    }
    float l = a.l + __shfl_xor(a.l, 32);
    l += ex2(ma.cst[16 + head] - shift);
    store_o64(ma.mix + (size_t)Rq * D + head * 64 + 4 * h, a.o0, a.o1, 1.f / l);
}

__device__ void attnD_item(const MixArgs& ma, int it, bool ctxq) {
    const int lane = otid() & 63, r = lane & 31, h = lane >> 5;
    const float shift = ma.cst[4];
    int b, head, Rq, rp = 0, j = 0, qr = 0, qc = 0;
    if (!ctxq) {
        b = it >> 9; head = (it >> 7) & 3; const int rem = it & 127; rp = rem >> 2; j = rem & 3;
        qr = 2 * rp + (r >> 4); qc = 16 * j + (r & 15);
        Rq = b * T + CTX + qr * 64 + qc;
    } else { b = it >> 5; head = (it >> 3) & 3; Rq = b * T + (it & 7) * 32 + r; }
    bf16x8 qf[4];
#pragma unroll
    for (int ks = 0; ks < 4; ++ks) qf[ks] = ldg8(ma.qkv + (size_t)Rq * NIN + 2304 + head * 64 + ks * 16 + h * 8);
    const bf16_t* kbase = ma.kg8 + (size_t)(b * 6 + 2 + head) * 64 * T;
    const bf16_t* vbase = ma.vt + (size_t)(b * NGRP + 10 + head) * 64 * T;
    A64 a; a.o0 = zero16(); a.o1 = zero16(); a.l = 0.f;
    {
        const int rs = min(max(qr - 4, 0), 56), cs = min(max(qc - 8, 0), 48);
        const int c0 = min(max(16 * j - 8, 0), 32);
        const int kr_lo = min(max(2 * rp - 4, 0), 56), kr_hi = min(max(2 * rp + 1 - 4, 0), 56) + 7;
        const int nwin = ctxq ? 0 : (kr_hi - kr_lo + 1);
        const LAS float* rpb = ma.rpb_l + head * 465;
        auto tk_of = [&](int i) { return (i < nwin) ? (CTX + (kr_lo + i) * 64 + c0) : (i - nwin) * 32; };
        auto soft = [&](int i, f32x16& sc) {
            float sum = 0.f;
            if (i < nwin) {
                const int kr = kr_lo + i;
                const bool rowok = (kr >= rs) && (kr < rs + 8);
#pragma unroll
                for (int e = 0; e < 16; ++e) {
                    const int kc = c0 + kidx(e, h);
                    const bool valid = rowok && (kc >= cs) && (kc < cs + 16);
                    float pp = 0.f;
                    if (valid) { const float bias = rpb[(kr - qr + 7) * 31 + (kc - qc + 15)]; pp = ex2(sc[e] + bias * LOG2E - shift); }
                    sum += pp; sc[e] = pp;
                }
            } else {
#pragma unroll
                for (int e = 0; e < 16; ++e) { const float pp = ex2(sc[e] - shift); sum += pp; sc[e] = pp; }
            }
            return sum;
        };
        attn64_run(kbase, vbase, qf, nwin + 8, r, h, tk_of, soft, a.o0, a.o1, a.l);
    }
    const float l = a.l + __shfl_xor(a.l, 32);
    store_o64(ma.mix + (size_t)Rq * D + 768 + head * 64 + 4 * h, a.o0, a.o1, 1.f / l);
}

template <bool SHIFT, bool COOP>
__device__ void attnB_item(const MixArgs& ma, int it, bool ctxq, LAS unsigned char* ring = nullptr) {
    const int tidb = otid(), lane = tidb & 63, r = lane & 31, h = lane >> 5;
    int b, head, qb;
    if (!ctxq) { b = it >> 9; head = (it >> 7) & 3; qb = it & 127; } else { b = it >> 5; head = (it >> 3) & 3; qb = it & 7; }
    const int Rq = b * T + (ctxq ? 0 : CTX) + qb * 32 + r;
    const float shift = ma.cst[3];
    bf16x8 q1[2], q2[2];
#pragma unroll
    for (int ks = 0; ks < 2; ++ks) {
        q1[ks] = ldg8(ma.qkv + (size_t)Rq * NIN + 512 + head * 64 + ks * 16 + h * 8);
        q2[ks] = ldg8(ma.qkv + (size_t)Rq * NIN + 512 + head * 64 + 32 + ks * 16 + h * 8);
    }
    const bf16_t* kp = ma.kfb + (size_t)((b * 4 + head) * 136) * 2048 + lane * 8;
    const bf16_t* vp = ma.vt + (size_t)(b * NGRP + 2 + head) * 64 * T + lane * 8;
    f32x16 o1a = zero16(), o1b = zero16(), o2a = zero16(), o2b = zero16();
    float l1 = 0.f, l2 = 0.f;
    const int ntile = ctxq ? 8 : (T / 32);
    const f32x16 sinit = zero16();
#define B_LOADK(KK, kt) do { const bf16_t* _k = kp + (kt) * 2048; KK[0] = ldg8(_k); KK[1] = ldg8(_k + 512); KK[2] = ldg8(_k + 1024); KK[3] = ldg8(_k + 1536); } while (0)
#define B_LOADV(VV, kt) do { const bf16_t* _v = vp + (kt) * 2048; VV[0] = ldg8(_v); VV[1] = ldg8(_v + 512); VV[2] = ldg8(_v + 1024); VV[3] = ldg8(_v + 1536); } while (0)
#define B_QK(KK, S1, S2) do { S1 = mfma(KK[0], q1[0], sinit); S1 = mfma(KK[1], q1[1], S1); S2 = mfma(KK[2], q2[0], sinit); S2 = mfma(KK[3], q2[1], S2); } while (0)
#define B_EXP8(S, o, P, L) do { \
        const float e0 = ex2(SHIFT ? S[o] - shift : S[o]), e1 = ex2(SHIFT ? S[o + 1] - shift : S[o + 1]), e2 = ex2(SHIFT ? S[o + 2] - shift : S[o + 2]), e3 = ex2(SHIFT ? S[o + 3] - shift : S[o + 3]); \
        const float e4 = ex2(SHIFT ? S[o + 4] - shift : S[o + 4]), e5 = ex2(SHIFT ? S[o + 5] - shift : S[o + 5]), e6 = ex2(SHIFT ? S[o + 6] - shift : S[o + 6]), e7 = ex2(SHIFT ? S[o + 7] - shift : S[o + 7]); \
        L += ((e0 + e1) + (e2 + e3)) + ((e4 + e5) + (e6 + e7)); P = pack8(e0, e1, e2, e3, e4, e5, e6, e7); } while (0)
#define B_SOFTPV(S1, S2, VV) do { \
        bf16x8 pa0, pa1, pb0, pb1; \
        B_EXP8(S1, 0, pa0, l1); B_EXP8(S1, 8, pa1, l1); B_EXP8(S2, 0, pb0, l2); B_EXP8(S2, 8, pb1, l2); \
        __builtin_amdgcn_sched_barrier(0); \
        o1a = mfma(VV[0], pa0, o1a); o1a = mfma(VV[1], pa1, o1a); o1b = mfma(VV[2], pa0, o1b); o1b = mfma(VV[3], pa1, o1b); \
        o2a = mfma(VV[0], pb0, o2a); o2a = mfma(VV[1], pb1, o2a); o2b = mfma(VV[2], pb0, o2b); o2b = mfma(VV[3], pb1, o2b); \
        } while (0)
    bf16x8 ones;
#pragma unroll
    for (int i = 0; i < 8; ++i) ones[i] = (short)0x3F80;
    f32x16 la = zero16(), lb = zero16();
    bf16x8 kf[4], vf[4];
    f32x16 s1, s2;
    if (COOP) {
        const bf16_t* gsrc = (tidb < 256) ? (ma.kfb + (size_t)((b * 4 + head) * 136) * 2048 + tidb * 8) : (ma.vt + (size_t)(b * NGRP + 2 + head) * 64 * T + (tidb - 256) * 8);
        LAS unsigned char* wdst = ring + tidb * 16;
        const LAS unsigned char* rsrc = ring + lane * 16;
        u32x4 rg = *(const u32x4*)gsrc;
        *(LAS u32x4*)wdst = rg;
        rg = *(const u32x4*)(gsrc + 2048);
        *(LAS u32x4*)(wdst + 8192) = rg;
        int st = 0, st2 = 2;
#pragma unroll 1
        for (int kt = 0; kt < ntile; ++kt) {
            if (kt + 2 < ntile) rg = *(const u32x4*)(gsrc + (size_t)(kt + 2) * 2048);
            __syncthreads();
            const LAS unsigned char* sp = rsrc + st * 8192;
#pragma unroll
            for (int f = 0; f < 4; ++f) { kf[f] = *(const LAS bf16x8*)(sp + f * 1024); vf[f] = *(const LAS bf16x8*)(sp + 4096 + f * 1024); }
            B_QK(kf, s1, s2);
            __builtin_amdgcn_sched_barrier(0);
            B_SOFTPV(s1, s2, vf);
            if (kt + 2 < ntile) *(LAS u32x4*)(wdst + st2 * 8192) = rg;
            st = (st == 2) ? 0 : st + 1; st2 = (st2 == 2) ? 0 : st2 + 1;
        }
        __syncthreads();
    } else {
    B_LOADK(kf, 0); B_LOADV(vf, 0);
#pragma unroll 1
    for (int kt = 0; kt < ntile; ++kt) {
        const int k1 = (kt + 1 < ntile) ? kt + 1 : ntile - 1;
        B_QK(kf, s1, s2);
        B_LOADK(kf, k1);
        __builtin_amdgcn_sched_barrier(0);
        B_SOFTPV(s1, s2, vf);
        B_LOADV(vf, k1);
        __builtin_amdgcn_sched_barrier(0);
    }
    }
    l1 += __shfl_xor(l1, 32); l2 += __shfl_xor(l2, 32);
#undef B_LOADK
#undef B_LOADV
#undef B_QK
#undef B_SOFTPV
#undef B_EXP8
    const float i1 = 1.f / l1, i2 = ma.cst[0] / l2;
    float ss = 0.f;
#pragma unroll
    for (int i = 0; i < 16; ++i) { o1a[i] = o1a[i] * i1 - o2a[i] * i2; o1b[i] = o1b[i] * i1 - o2b[i] * i2; ss += o1a[i] * o1a[i] + o1b[i] * o1b[i]; }
    ss += __shfl_xor(ss, 32);
    const float mul = rsqrtf(ss * (1.f / 64.f) + EPS) * ma.cst[1];
#pragma unroll
    for (int i = 0; i < 16; ++i) { const int d = crow(i, h); o1a[i] *= ma.gains_l[d]; o1b[i] *= ma.gains_l[32 + d]; }
    store_o64(ma.mix + (size_t)Rq * D + 256 + head * 64 + 4 * h, o1a, o1b, mul);
}

__device__ void retKV_item(const MixArgs& ma, int it, float* kvout) {
    const int lane = otid() & 63, r = lane & 31, h = lane >> 5;
    const int dir = it & 1, c = (it >> 1) % 34, bh = (it >> 1) / 34, b = bh >> 2, head = bh & 3;
    const float lg = dir ? ma.cst[12 + head] : ma.cst[8 + head];
    const bf16_t* vp = ma.vt + (size_t)(b * NGRP + 6 + head) * 64 * T + v8off(c * 128, r, h);
    const bf16_t* kp = ma.vt + (size_t)(b * NGRP + 14 + head) * 64 * T + v8off(c * 128, r, h);
    f32x16 acc[2][2];
    acc[0][0] = zero16(); acc[0][1] = zero16(); acc[1][0] = zero16(); acc[1][1] = zero16();
#pragma unroll
    for (int ks = 0; ks < 8; ++ks) {
        const bf16x8 v0 = ldg8(vp + ks * 1024), v1 = ldg8(vp + 256 + ks * 1024);
        bf16x8 k0 = ldg8(kp + ks * 1024), k1 = ldg8(kp + 256 + ks * 1024);
        float w[8];
#pragma unroll
        for (int j = 0; j < 8; ++j) { const int tl = ks * 16 + h * 8 + j; w[j] = ex2(lg * (float)(dir ? tl : (127 - tl))); }
        float f0[8], f1[8];
#pragma unroll
        for (int j = 0; j < 8; ++j) { f0[j] = bf2f((unsigned short)k0[j]) * w[j]; f1[j] = bf2f((unsigned short)k1[j]) * w[j]; }
        k0 = pack8(f0[0], f0[1], f0[2], f0[3], f0[4], f0[5], f0[6], f0[7]);
        k1 = pack8(f1[0], f1[1], f1[2], f1[3], f1[4], f1[5], f1[6], f1[7]);
        acc[0][0] = mfma(v0, k0, acc[0][0]); acc[0][1] = mfma(v0, k1, acc[0][1]);
        acc[1][0] = mfma(v1, k0, acc[1][0]); acc[1][1] = mfma(v1, k1, acc[1][1]);
    }
    float* dst = kvout + ((size_t)((bh * 2 + dir) * 34 + c)) * 4096;
#pragma unroll
    for (int db = 0; db < 2; ++db)
#pragma unroll
        for (int nb = 0; nb < 2; ++nb)
#pragma unroll
            for (int i = 0; i < 16; ++i) dst[(db * 32 + crow(i, h)) * 64 + nb * 32 + r] = acc[db][nb][i];
}

__device__ void ret_scan(const float* __restrict__ cst, const float* __restrict__ kv, bf16_t* __restrict__ sin) {
    const int n = NB * 4 * 2 * 4096;
    for (int e = blockIdx.x * 512 + otid(); e < n; e += gridDim.x * 512) {
        const int el = e & 4095, bhd = e >> 12, dir = bhd & 1, head = (bhd >> 1) & 3;
        const float lg = dir ? cst[12 + head] : cst[8 + head];
        const float dec = ex2(lg * 128.f);
        const size_t base = (size_t)bhd * 34 * 4096 + el;
        float v[34];
#pragma unroll
        for (int p = 0; p < 34; ++p) v[p] = kv[base + (size_t)p * 4096];
        float S = 0.f;
        if (dir == 0) {
#pragma unroll
            for (int p = 0; p < 34; ++p) { sin[base + (size_t)p * 4096] = (bf16_t)(pk2(S, 0.f) & 0xffffu); S = S * dec + v[p]; }
        } else {
            sin[base + 4096] = (bf16_t)(pk2(S, 0.f) & 0xffffu); S = S * dec + v[1];
            sin[base] = (bf16_t)(pk2(S, 0.f) & 0xffffu); S = S * dec + v[0];
#pragma unroll
            for (int c = 33; c >= 2; --c) { sin[base + (size_t)c * 4096] = (bf16_t)(pk2(S, 0.f) & 0xffffu); S = S * dec + v[c]; }
        }
    }
}

__device__ void retOut_item(const MixArgs& ma, int it) {
    const int lane = otid() & 63, r = lane & 31, h = lane >> 5;
    const int qs = it & 3, c = (it >> 2) % 34, bh = (it >> 2) / 34, b = bh >> 2, head = bh & 3;
    const float lgf = ma.cst[8 + head], lgb = ma.cst[12 + head];
    const int R0 = b * T + c * 128, Rq = R0 + qs * 32 + r, iq = qs * 32 + r;
    bf16x8 qf[4];
#pragma unroll
    for (int ks = 0; ks < 4; ++ks) qf[ks] = ldg8(ma.qkv + (size_t)Rq * NIN + 1280 + head * 64 + ks * 16 + h * 8);
    const bf16_t* kbase = ma.qkv + 1536 + head * 64 + h * 8;
    const bf16_t* vbase = ma.vt + (size_t)(b * NGRP + 6 + head) * 64 * T + v8off(c * 128, r, h);
    f32x16 o0 = zero16(), o1 = zero16();
    {
        bf16x8 kc[4], vc[4], kn[4], vn[4];
        const bf16_t* kp0 = kbase + (size_t)(R0 + keyperm(r)) * NIN;
#pragma unroll
        for (int ks = 0; ks < 4; ++ks) kc[ks] = ldg8(kp0 + ks * 16);
        vc[0] = ldg8(vbase); vc[1] = ldg8(vbase + 1024); vc[2] = ldg8(vbase + 256); vc[3] = ldg8(vbase + 1280);
#pragma unroll 1
        for (int kb = 0; kb < 4; ++kb) {
            {
                const int kn_i = (kb < 3) ? kb + 1 : kb;
                const bf16_t* kp = kp0 + (size_t)(kn_i * 32) * NIN; const bf16_t* vp = vbase + kn_i * 2048;
#pragma unroll
                for (int ks = 0; ks < 4; ++ks) kn[ks] = ldg8(kp + ks * 16);
                vn[0] = ldg8(vp); vn[1] = ldg8(vp + 1024); vn[2] = ldg8(vp + 256); vn[3] = ldg8(vp + 1280);
            }
            __builtin_amdgcn_sched_barrier(0);
            f32x16 s = zero16();
#pragma unroll
            for (int ks = 0; ks < 4; ++ks) s = mfma(kc[ks], qf[ks], s);
#pragma unroll
            for (int i = 0; i < 16; ++i) {
                const int jk = kb * 32 + kidx(i, h);
                const int dlt = iq - jk;
                const float w = (dlt > 0) ? ex2(lgf * (float)dlt) : (dlt < 0) ? ex2(lgb * (float)(-dlt)) : 2.f;
                s[i] *= w;
            }
            bf16x8 p0, p1; pack_p(s, p0, p1);
            o0 = mfma(vc[0], p0, o0); o1 = mfma(vc[2], p0, o1); o0 = mfma(vc[1], p1, o0); o1 = mfma(vc[3], p1, o1);
            __builtin_amdgcn_sched_barrier(0);
#pragma unroll
            for (int ks = 0; ks < 4; ++ks) { kc[ks] = kn[ks]; vc[ks] = vn[ks]; }
        }
    }
#pragma unroll
    for (int dir = 0; dir < 2; ++dir) {
        const bf16_t* sp = ma.sin + ((size_t)((bh * 2 + dir) * 34 + c)) * 4096 + r * 64 + h * 8;
        f32x16 x0 = zero16(), x1 = zero16();
#pragma unroll
        for (int ks = 0; ks < 4; ++ks) { x0 = mfma(ldg8(sp + ks * 16), qf[ks], x0); x1 = mfma(ldg8(sp + 32 * 64 + ks * 16), qf[ks], x1); }
        const float w = dir ? ex2(lgb * (float)(128 - iq)) : ex2(lgf * (float)(iq + 1));
#pragma unroll
        for (int i = 0; i < 16; ++i) { o0[i] += w * x0[i]; o1[i] += w * x1[i]; }
    }
    float ss = 0.f;
#pragma unroll
    for (int i = 0; i < 16; ++i) ss += o0[i] * o0[i] + o1[i] * o1[i];
    ss += __shfl_xor(ss, 32);
    const float mul = rsqrtf(ss * (1.f / 64.f) + EPS);
    const bf16_t* gp = ma.qkv + (size_t)Rq * NIN + 2048 + head * 64 + 4 * h;
#pragma unroll
    for (int q4 = 0; q4 < 4; ++q4) {
        const u32x2 ga = *(const u32x2*)(gp + 8 * q4), gb = *(const u32x2*)(gp + 32 + 8 * q4);
#pragma unroll
        for (int e = 0; e < 4; ++e) {
            const int i = 4 * q4 + e, d = crow(i, h);
            const float gta = bf2f((unsigned short)((e & 1) ? (ga[e >> 1] >> 16) : (ga[e >> 1] & 0xffffu)));
            const float gtb = bf2f((unsigned short)((e & 1) ? (gb[e >> 1] >> 16) : (gb[e >> 1] & 0xffffu)));
            o0[i] *= ma.gains_l[64 + d] * gta; o1[i] *= ma.gains_l[96 + d] * gtb;
        }
    }
    store_o64(ma.mix + (size_t)Rq * D + 512 + head * 64 + 4 * h, o0, o1, mul);
}

__global__ void __launch_bounds__(512) fwd_kernel(Params p) {
    extern __shared__ __attribute__((aligned(16))) unsigned char lds[];
    cg::grid_group grid = cg::this_grid();
    volatile LAS unsigned* xbw = (volatile LAS unsigned*)(lds + LDS_MAIN);
    if (threadIdx.x == 0) { xbw[0] = 0u; xbw[1] = 0u; xbw[2] = 0u; xbw[3] = 0u; }
    __syncthreads();
    XcdBarrier xb = xcd_barrier_post((unsigned*)(p.ws + WS_BAR), xbw);

    unsigned char* ws = p.ws;
    float* tab = (float*)(ws + WS_TAB);
    float* modb = (float*)(ws + WS_MOD);
    float* ctxb = (float*)(ws + WS_CTXB);
    bf16_t* act = (bf16_t*)(ws + WS_ACT);
    float* kvb = (float*)(ws + WS_KV);
    bf16_t* sinb = (bf16_t*)(ws + WS_SIN);
    bf16_t* qkv = (bf16_t*)(ws + WS_QKV);
    bf16_t* vt = (bf16_t*)(ws + WS_VT);
    bf16_t* ub = (bf16_t*)(ws + WS_QKV);
    const bf16_t* w_in = (const bf16_t*)(ws + WS_W + W_IN_OFF);
    const bf16_t* w_out = (const bf16_t*)(ws + WS_W + W_OUT_OFF);
    const bf16_t* w_1 = (const bf16_t*)(ws + WS_W + W_1_OFF);
    const bf16_t* w_2 = (const bf16_t*)(ws + WS_W + W_2_OFF);
    const int nw = gridDim.x * 8;
    float* slabb = (float*)(ws + WS_KV);
    constexpr int NSPLIT = 8;
    float* slabb2 = (float*)(ws + WS_QKV + 142606336);
#define GW (blockIdx.x * 8 + (otid() >> 6))

    { int nr0 = (PROBE_DUP == 6) ? 2 : 1; asm volatile("" : "+s"(nr0));
#pragma unroll 1
      for (int rep = 0; rep < nr0; ++rep) {
    if (blockIdx.x == 0) prep_tables(p);
    for (int it = blockIdx.x; it < 192; it += gridDim.x) mod_item(p, it, lds);
    conv_layer(p, 0, lds, 0, 768, 0, gridDim.x);
      } }
    if (p.ws == nullptr) grid.sync();
    if (threadIdx.x == 0) { unsigned nloc, nx; xcd_barrier_complete(xb.bar, xb.x, nloc, nx); xbw[0] = nloc; xbw[1] = nx; }
    __syncthreads();
    xcd_barrier(xb);

#pragma nounroll
    for (int l = 0; l < 2; ++l) {
        const float* modl = modb + l * 5 * 6144;
        const float* cst = tab + 3072 + l * 32;
        const float* lat_in = (l == 0) ? p.in[0] : p.out;
        const float* ctx_in = (l == 0) ? p.in[2] : ctxb;
        if (l == 1 && (1088 % gridDim.x) == 0) conv_layer(p, 1, lds, 0, 768, 0, gridDim.x);
        { int nr = (PROBE_DUP == 4) ? 2 : 1; asm volatile("" : "+s"(nr));
#pragma unroll 1
          for (int rep = 0; rep < nr; ++rep) norm_phase(lat_in, ctx_in, p.in[6] + l * D, modl, 0, 1024, act, false, slabb, (l == 1) ? NSPLIT : 0, modb + 4 * 6144 + 5120, nullptr, slabb2); }
        xcd_barrier(xb);
        if (PROBE_DUP == 7) xcd_barrier(xb);
        MixArgs ma{}; ma.qkv = qkv; ma.vt = vt; ma.kfb = (const bf16_t*)(ws + WS_KFB); ma.kg8 = (const bf16_t*)(ws + WS_KG8); ma.mix = act; ma.cst = cst; ma.rpb = p.in[25] + l * 1860; ma.subln = p.in[19] + l * 64; ma.gn = p.in[22] + l * 64; ma.sin = sinb;
        const int nb4 = 816 % gridDim.x;
        const bool kv_early = nb4 != 0;
        {
            EpiArgs ea{}; ea.out = qkv; ea.ldo = NIN; ea.vt = vt; ea.kfb = (bf16_t*)(ws + WS_KFB); ea.kg8 = (bf16_t*)(ws + WS_KG8); ea.tab = tab;
            ea.aq = p.in[10] + l * 64; ea.ak = p.in[11] + l * 64; ea.bq = p.in[13] + l * 32; ea.bk = p.in[14] + l * 32; ea.dq = p.in[23] + l * 64; ea.dk = p.in[24] + l * 64;
            unsigned* kvcnt = (unsigned*)(ws + WS_BAR) + 3520 + l * 64;
            ea.kvcnt = kv_early ? kvcnt : nullptr;
            { int nr8 = (PROBE_DUP == 8) ? 2 : 1; asm volatile("" : "+s"(nr8));
#pragma unroll 1
              for (int rep = 0; rep < nr8; ++rep) gemm_phase8<EPI_INPROJ>(act, w_in, 1024, NIN, ea, lds, false); }
            conv_layer(p, l, lds, 768, 3072, nb4, gridDim.x - nb4);
            if (kv_early && (int)blockIdx.x >= nb4) {
                if (threadIdx.x == 0) {
                    unsigned sp = 0;
                    while (__hip_atomic_load(kvcnt, __ATOMIC_RELAXED, __HIP_MEMORY_SCOPE_AGENT) < 136u) { __builtin_amdgcn_s_sleep(2); if (++sp > (1u << 22)) { atomicAdd((unsigned*)(ws + WS_BAR) + XB_TMO, 1u); break; } }
                    __builtin_amdgcn_fence(__ATOMIC_ACQUIRE, "agent");
                    asm volatile("s_waitcnt vmcnt(0)" ::: "memory");
                }
                __syncthreads();
                const int nidle = gridDim.x - nb4;
                for (int it = ((int)blockIdx.x - nb4) * 8 + (otid() >> 6); it < NB * 4 * 34 * 2; it += nidle * 8) retKV_item(ma, it, kvb);
            }
        }
        xcd_barrier(xb);
        if (!kv_early) {
            for (int it = GW; it < NB * 4 * 34 * 2; it += nw) retKV_item(ma, it, kvb);
            xcd_barrier(xb);
        }
        { int nr = (PROBE_DUP == 5) ? 2 : 1; asm volatile("" : "+s"(nr));
#pragma unroll 1
          for (int rep = 0; rep < nr; ++rep) ret_scan(cst, kvb, sinb); }
        xcd_barrier(xb);
        if (PROBE_DUP == 7) xcd_barrier(xb);
        {
            LAS float* rl = (LAS float*)(lds + 65536);
            for (int i = otid(); i < 1860; i += 512) rl[i] = ma.rpb[i];
            if (otid() < 128) rl[2048 + otid()] = (otid() < 64) ? ma.subln[otid()] : ma.gn[otid() - 64];
            ma.rpb_l = rl; ma.gains_l = rl + 2048;
            __syncthreads();
        }
        {
            const int wv = otid() >> 6;
            const bool noshift = cst[3] <= 64.f;
            for (int itb = blockIdx.x; itb < 256; itb += gridDim.x) {
                if (wv < 4) {
#pragma unroll 1
                    for (int k = 0; k < 2; ++k) {
                        const int it = itb * 8 + 2 * wv + k;
                        if (noshift) attnB_item<false, false>(ma, it, false); else attnB_item<true, false>(ma, it, false);
                    }
                } else {
                    __builtin_amdgcn_s_setprio(2);
#pragma unroll 1
                    for (int k = 0; k < 2; ++k) {
                        const int it = itb * 8 + 2 * (wv - 4) + k;
                        attnA_item(ma, it, false);
                        attnD_item(ma, it, false);
                        retOut_item(ma, ((it >> 7) * 34 + 2 + ((it & 127) >> 2)) * 4 + (it & 3));
                    }
                    __builtin_amdgcn_s_setprio(0);
                }
            }
            if (l == 0 && wv >= 4) {
                const int pw = blockIdx.x * 4 + (wv - 4), npw = gridDim.x * 4;
                for (int i = pw; i < 128; i += npw) retOut_item(ma, ((i >> 3) * 34 + ((i & 7) >> 2)) * 4 + (i & 3));
                for (int it = (pw + npw - 256 % npw) % npw; it < 128; it += npw) attnB_item<true, false>(ma, it, true);
                for (int it = (pw + npw - 512 % npw) % npw; it < 128; it += npw) attnA_item(ma, it, true);
                for (int it = (pw + npw - 768 % npw) % npw; it < 128; it += npw) attnD_item(ma, it, true);
            }
        }
        xcd_barrier(xb);
        if (PROBE_DUP == 7) xcd_barrier(xb);
        {
            EpiArgs ea{}; ea.lat_in = lat_in; ea.ctx_in = ctx_in; ea.lat_out = p.out; ea.ctx_out = ctxb; ea.gate = modl + 2048;
            gemm_phase8<EPI_RESID>(act, w_out, 1024, 1024, ea, lds, true, (l == 0) ? NSPLIT : 0, slabb, slabb2);
        }
        xcd_barrier(xb);
        if (PROBE_DUP == 7) xcd_barrier(xb);
        { int nr = (PROBE_DUP == 4) ? 2 : 1; asm volatile("" : "+s"(nr));
#pragma unroll 1
          for (int rep = 0; rep < nr; ++rep) norm_phase(p.out, (l == 0) ? ctx_in : ctxb, p.in[7] + l * D, modl, 3072, 4096, act, l == 1, slabb, (l == 0) ? NSPLIT : 0, modl + 4 * 6144 + 2048, ctxb, slabb2); }
        xcd_barrier(xb);
        if (PROBE_DUP == 7) xcd_barrier(xb);
        {
            EpiArgs ea{}; ea.out = ub; ea.ldo = DFF;
            int nrep = (PROBE_DUP == 1) ? 2 : 1; asm volatile("" : "+s"(nrep));
#pragma unroll 1
            for (int rep = 0; rep < nrep; ++rep) gemm_phase8<EPI_RELU2>(act, w_1, 1024, DFF, ea, lds, l == 1);
            if (l == 0 && (1088 % gridDim.x) != 0) { const int nb5 = 1088 % gridDim.x; conv_layer(p, 1, lds, 0, 768, nb5, gridDim.x - nb5); }
        }
        xcd_barrier(xb);
        if (PROBE_DUP == 7) xcd_barrier(xb);
        {
            EpiArgs ea{}; ea.lat_in = p.out; ea.ctx_in = ctxb; ea.lat_out = p.out; ea.ctx_out = ctxb; ea.gate = modl + 5120;
            gemm_phase8<EPI_RESID>(ub, w_2, 4096, 1024, ea, lds, true, (l == 0) ? NSPLIT : 0, slabb, slabb2);
        }
        if (l == 0) xcd_barrier(xb);
    }
}

extern "C" void kernel_launch(void* const* d_in, const int* in_sizes, int n_in, void* d_out, int out_size, void* d_ws, size_t ws_size, hipStream_t stream) {
    static int grid_blocks = 0;
    if (!grid_blocks) {
        int dev = 0, cus = 0, per_cu = 0;
        hipGetDevice(&dev);
        hipDeviceGetAttribute(&cus, hipDeviceAttributeMultiprocessorCount, dev);
        hipFuncSetAttribute((const void*)fwd_kernel, hipFuncAttributeMaxDynamicSharedMemorySize, LDS_BYTES);
        hipOccupancyMaxActiveBlocksPerMultiprocessor(&per_cu, (const void*)fwd_kernel, 512, LDS_BYTES);
        if (per_cu < 1) { fprintf(stderr, "kernel_launch: occupancy query says %d blocks/CU\n", per_cu); per_cu = 1; }
        grid_blocks = cus;
    }
    if (n_in != 28 || ws_size < WS_END) { fprintf(stderr, "kernel_launch: bad args n_in %d ws %zu need %zu\n", n_in, ws_size, (size_t)WS_END); return; }
    hipMemsetAsync((char*)d_ws + WS_BAR, 0, 16384, stream);
    Params p{};
    for (int i = 0; i < 28; ++i) p.in[i] = (const float*)d_in[i];
    p.out = (float*)d_out; p.ws = (unsigned char*)d_ws;
    void* args[] = {&p};
    hipError_t e = hipLaunchCooperativeKernel((const void*)fwd_kernel, dim3(grid_blocks), dim3(512), args, LDS_BYTES, stream);
    if (e != hipSuccess) fprintf(stderr, "cooperative launch failed: %s (grid %d)\n", hipGetErrorString(e), grid_blocks);
}
```
